# Optimizing an MI355X kernel written in HIP

```python
import math
import jax, jax.numpy as jnp
from jax import lax
import numpy as np

D_MODEL = 1024
BATCH = 32
SEQ = 2048
DEPTH = 2

CHUNK = 64
N_MIXERS = 2
N_FOX = (DEPTH + N_MIXERS - 1) // N_MIXERS
N_S5 = DEPTH // N_MIXERS
FOX_HEADS = 16
FOX_HEAD_DIM = 64
FOX_WIDTH = FOX_HEADS * FOX_HEAD_DIM
Q_BLOCK = 128
FORGET_BIAS_INIT = 2.0
S5_WIDTH = D_MODEL
S5_GROUP = 16
S5_GROUPS = S5_WIDTH // S5_GROUP
S5_STATE = 64
DT_MIN = 1e-3
DT_MAX = 1e-1
PLE_DIM = 256
RMS_EPS = 1e-6
NEG_INF = -1e30

kernel_name = "fox_s5_interleaved_sandwich_ple"


def rmsnorm(x, g):
    xf = x.astype(jnp.float32)
    var = jnp.mean(xf * xf, axis=-1, keepdims=True)
    return (xf * lax.rsqrt(var + RMS_EPS) * g.astype(jnp.float32)).astype(x.dtype)


def fox_mixer(h, w_in, b_f, w_out):
    bsz, seq, _ = h.shape
    proj = h @ w_in
    q, k, v, z, fl = jnp.split(
        proj, [FOX_WIDTH, 2 * FOX_WIDTH, 3 * FOX_WIDTH, 4 * FOX_WIDTH], axis=-1)
    q = q.reshape(bsz, seq, FOX_HEADS, FOX_HEAD_DIM)
    k = k.reshape(bsz, seq, FOX_HEADS, FOX_HEAD_DIM)
    v = v.reshape(bsz, seq, FOX_HEADS, FOX_HEAD_DIM)
    log_f = jax.nn.log_sigmoid(fl.astype(jnp.float32) + b_f.astype(jnp.float32))
    cum = jnp.cumsum(log_f, axis=1).transpose(0, 2, 1)
    scale = FOX_HEAD_DIM ** -0.5
    outs = []
    for start in range(0, seq, Q_BLOCK):
        end = start + Q_BLOCK
        s = jnp.einsum('bqhd,bkhd->bhqk', q[:, start:end], k[:, :end]).astype(jnp.float32) * scale
        bias = cum[:, :, start:end, None] - cum[:, :, None, :end]
        qpos = jnp.arange(start, end)[:, None]
        kpos = jnp.arange(end)[None, :]
        logits = jnp.where(kpos <= qpos, s + bias, NEG_INF)
        pr = jax.nn.softmax(logits, axis=-1)
        outs.append(jnp.einsum('bhqk,bkhd->bqhd', pr.astype(v.dtype), v[:, :end]))
    o = jnp.concatenate(outs, axis=1).reshape(bsz, seq, FOX_WIDTH)
    return (o * jax.nn.silu(z)) @ w_out


def _ssm_combine(e1, e2):
    a1r, a1i, b1r, b1i = e1
    a2r, a2i, b2r, b2i = e2
    ar = a2r * a1r - a2i * a1i
    ai = a2r * a1i + a2i * a1r
    br = a2r * b1r - a2i * b1i + b2r
    bi = a2r * b1i + a2i * b1r + b2i
    return (ar, ai, br, bi)


def s5_mixer(h, w_in, lam_re, lam_im, log_dt, b_re, b_im, c_re, c_im, d_skip, w_glu, b_glu, w_out):
    bsz, seq, _ = h.shape
    f32 = jnp.float32
    proj = h @ w_in
    u, z = jnp.split(proj, [S5_WIDTH], axis=-1)
    u32 = u.astype(f32).reshape(bsz, seq, S5_GROUPS, S5_GROUP)
    lr = lam_re.astype(f32)
    li = lam_im.astype(f32)
    dt = jnp.exp(log_dt.astype(f32))[:, None]
    mag = jnp.exp(lr * dt)
    lb_re = mag * jnp.cos(li * dt)
    lb_im = mag * jnp.sin(li * dt)
    den = lr * lr + li * li
    num_re = lb_re - 1.0
    num_im = lb_im
    coef_re = (num_re * lr + num_im * li) / den
    coef_im = (num_im * lr - num_re * li) / den
    br = b_re.astype(f32)
    bi = b_im.astype(f32)
    bb_re = coef_re[..., None] * br - coef_im[..., None] * bi
    bb_im = coef_re[..., None] * bi + coef_im[..., None] * br
    bu_re = jnp.einsum('blgi,gpi->lbgp', u32, bb_re)
    bu_im = jnp.einsum('blgi,gpi->lbgp', u32, bb_im)
    a_re = jnp.broadcast_to(lb_re[None, None], (seq, 1, S5_GROUPS, S5_STATE))
    a_im = jnp.broadcast_to(lb_im[None, None], (seq, 1, S5_GROUPS, S5_STATE))
    _, _, h_re, h_im = lax.associative_scan(_ssm_combine, (a_re, a_im, bu_re, bu_im), axis=0)
    y = (jnp.einsum('lbgp,gip->blgi', h_re, c_re.astype(f32))
         - jnp.einsum('lbgp,gip->blgi', h_im, c_im.astype(f32)))
    y = y.reshape(bsz, seq, S5_WIDTH) + d_skip.astype(f32) * u.astype(f32)
    y = y.astype(h.dtype)
    g = jax.nn.gelu(y)
    y = g * jax.nn.sigmoid(g @ w_glu + b_glu)
    return (y * jax.nn.silu(z)) @ w_out


def setup_inputs(seed: int = 0) -> dict:
    key = jax.random.key(seed)
    ks = jax.random.split(key, 24)
    nrm = jax.random.normal
    d = D_MODEL
    x = nrm(ks[0], (BATCH, SEQ, d), jnp.float32)
    p = nrm(ks[1], (DEPTH, BATCH, SEQ, PLE_DIM), jnp.float32)
    ln_pre = 1.0 + 0.05 * nrm(ks[2], (DEPTH, d), jnp.float32)
    ln_post = 1.0 + 0.05 * nrm(ks[3], (DEPTH, d), jnp.float32)
    fox_w_in = nrm(ks[4], (N_FOX, d, 4 * FOX_WIDTH + FOX_HEADS), jnp.float32) * d ** -0.5
    fox_b_f = FORGET_BIAS_INIT + 0.5 * nrm(ks[5], (N_FOX, FOX_HEADS), jnp.float32)
    fox_w_out = nrm(ks[6], (N_FOX, FOX_WIDTH, d), jnp.float32) * FOX_WIDTH ** -0.5
    s5_w_in = nrm(ks[7], (N_S5, d, 2 * S5_WIDTH), jnp.float32) * d ** -0.5
    s5_lambda_re = -0.5 * jnp.exp(0.02 * nrm(ks[8], (N_S5, S5_GROUPS, S5_STATE), jnp.float32))
    s5_lambda_im = (math.pi * jnp.arange(S5_STATE, dtype=jnp.float32)[None, None, :]
                    + 0.01 * nrm(ks[9], (N_S5, S5_GROUPS, S5_STATE), jnp.float32))
    s5_log_dt = jax.random.uniform(ks[10], (N_S5, S5_GROUPS), jnp.float32,
                                   minval=math.log(DT_MIN), maxval=math.log(DT_MAX))
    bscale = (2.0 * S5_GROUP) ** -0.5
    s5_b_re = nrm(ks[11], (N_S5, S5_GROUPS, S5_STATE, S5_GROUP), jnp.float32) * bscale
    s5_b_im = nrm(ks[12], (N_S5, S5_GROUPS, S5_STATE, S5_GROUP), jnp.float32) * bscale
    cscale = S5_STATE ** -0.5
    s5_c_re = nrm(ks[13], (N_S5, S5_GROUPS, S5_GROUP, S5_STATE), jnp.float32) * cscale
    s5_c_im = nrm(ks[14], (N_S5, S5_GROUPS, S5_GROUP, S5_STATE), jnp.float32) * cscale
    s5_d = nrm(ks[15], (N_S5, S5_WIDTH), jnp.float32)
    s5_w_glu = nrm(ks[16], (N_S5, S5_WIDTH, S5_WIDTH), jnp.float32) * S5_WIDTH ** -0.5
    s5_b_glu = 0.01 * nrm(ks[17], (N_S5, S5_WIDTH), jnp.float32)
    s5_w_out = nrm(ks[18], (N_S5, S5_WIDTH, d), jnp.float32) * S5_WIDTH ** -0.5
    ple_w_proj = nrm(ks[19], (DEPTH, PLE_DIM, d), jnp.float32) * PLE_DIM ** -0.5
    ple_w_gate = nrm(ks[20], (DEPTH, d, d), jnp.float32) * d ** -0.5
    ple_b_gate = 0.01 * nrm(ks[21], (DEPTH, d), jnp.float32)
    return {"x": x, "p": p, "ln_pre": ln_pre, "ln_post": ln_post,
            "fox_w_in": fox_w_in, "fox_b_f": fox_b_f, "fox_w_out": fox_w_out,
            "s5_w_in": s5_w_in, "s5_lambda_re": s5_lambda_re, "s5_lambda_im": s5_lambda_im,
            "s5_log_dt": s5_log_dt, "s5_b_re": s5_b_re, "s5_b_im": s5_b_im,
            "s5_c_re": s5_c_re, "s5_c_im": s5_c_im, "s5_d": s5_d,
            "s5_w_glu": s5_w_glu, "s5_b_glu": s5_b_glu, "s5_w_out": s5_w_out,
            "ple_w_proj": ple_w_proj, "ple_w_gate": ple_w_gate, "ple_b_gate": ple_b_gate}


def reference(x, p, ln_pre, ln_post, fox_w_in, fox_b_f, fox_w_out, s5_w_in, s5_lambda_re,
              s5_lambda_im, s5_log_dt, s5_b_re, s5_b_im, s5_c_re, s5_c_im, s5_d, s5_w_glu,
              s5_b_glu, s5_w_out, ple_w_proj, ple_w_gate, ple_b_gate):
    for i in range(DEPTH):
        h = rmsnorm(x, ln_pre[i])
        j = i // N_MIXERS
        if i % N_MIXERS == 0:
            y = fox_mixer(h, fox_w_in[j], fox_b_f[j], fox_w_out[j])
        else:
            y = s5_mixer(h, s5_w_in[j], s5_lambda_re[j], s5_lambda_im[j], s5_log_dt[j],
                         s5_b_re[j], s5_b_im[j], s5_c_re[j], s5_c_im[j], s5_d[j],
                         s5_w_glu[j], s5_b_glu[j], s5_w_out[j])
        x = x + rmsnorm(y, ln_post[i])
        gate = jax.nn.sigmoid(x @ ple_w_gate[i] + ple_b_gate[i])
        x = x + (p[i] @ ple_w_proj[i]) * gate
    return x
```

```cpp
#include <hip/hip_runtime.h>
#include <hip/hip_bf16.h>
#include <cstdio>
#include <cstdint>
#include <cmath>
namespace pg8 {
#define PG8_LAS __attribute__((address_space(3)))
typedef unsigned short bf16_t;
typedef short bf16x8 __attribute__((ext_vector_type(8)));
typedef float f32x4 __attribute__((ext_vector_type(4)));
typedef unsigned u32x4 __attribute__((ext_vector_type(4)));
constexpr int BM = 256, BK = 64, HALF = 128, HTB = HALF * BK * 2  , STAGE_BYTES = 8 * HTB, NXCD = 8, WGM = 8;

__host__ __device__ __forceinline__ int lds_byte(int r, int c) { const int st = (r >> 4) * 2 + (c >> 5), rr = r & 15, cc = c & 31, ob = rr * 64 + cc * 2; return st * 1024 + (ob ^ (((ob >> 9) & 1) << 5)); }
__host__ __device__ __forceinline__ void stage_rc(int b, int& R, int& C) { const int st = b / 1024, sb = b % 1024, swz = sb ^ (((sb >> 9) & 1) << 5); R = (st >> 1) * 16 + swz / 64; C = (st & 1) * 32 + (swz % 64) / 2; }
__host__ __device__ __forceinline__ int perm32(int rho) { const int n = rho >> 4, i = rho & 15; return 8 * (i >> 2) + 4 * n + (i & 3); }

struct Unit { int pm, pn; };
struct Gemm { const bf16_t* A; const bf16_t* Bt; int M, N, K; };

struct StaticOrder {
    int nM, nN, nwg, G, c;
    __host__ __device__ void init(int M, int N, int G_, int c_) { nM = M / BM; nN = N / BM; nwg = nM * nN; G = G_; c = c_; }
    __host__ __device__ bool next(int i, Unit& u) const {
        const long L = (long)i * G + c; if (L >= nwg) return false;
        int wgid = (int)L; { const int q = nwg / NXCD, r = nwg % NXCD, xcd = wgid % NXCD, off = wgid / NXCD; wgid = (xcd < r ? xcd * (q + 1) : r * (q + 1) + (xcd - r) * q) + off; }
        const int nig = WGM * nN, gid = wgid / nig, fm = gid * WGM, gsz = (nM - fm) < WGM ? (nM - fm) : WGM;
        u.pm = fm + ((wgid % nig) % gsz); u.pn = (wgid % nig) / gsz; return true;
    }
    __device__ __forceinline__ void a_ready(const Unit&) const {}
    __device__ __forceinline__ void done(const Unit&) const {}
};

__device__ __forceinline__ unsigned cvt_pk_bf16(float lo, float hi) { unsigned r; asm volatile("v_cvt_pk_bf16_f32 %0, %1, %2" : "=v"(r) : "v"(lo), "v"(hi)); return r; }
typedef float f32x2 __attribute__((ext_vector_type(2)));
template <class F> struct Epi8 {
    static constexpr bool PERM = true, AFTER_DRAIN = false; F f; float* ssq;
    __device__ __forceinline__ void operator()(const f32x4 (&acc)[2][2][4][2], const Unit& u, int wr, int wc, int fr, int fq) const {
        const int row0 = u.pm * BM + wr * 64 + fr, col0 = u.pn * BM + wc * 32 + 8 * fq;
#pragma unroll
        for (int ai = 0; ai < 2; ++ai)
#pragma unroll
            for (int m = 0; m < 4; ++m) { const int row = row0 + ai * HALF + m * 16; float s = 0.f;
#pragma unroll
                for (int bj = 0; bj < 2; ++bj) { float v[8];
#pragma unroll
                    for (int e = 0; e < 4; ++e) { v[e] = acc[ai][bj][m][0][e]; v[4 + e] = acc[ai][bj][m][1][e]; }
                    s += f(row, col0 + bj * HALF, v); }
                if (F::HAS_SSQ) { s += __shfl_xor(s, 16); s += __shfl_xor(s, 32); if (fq == 0) ssq[(size_t)row * 16 + (u.pn & 3) * 4 + wc] = s; } }
    }
};
template <class F> struct Epi4 {
    static constexpr bool PERM = false, AFTER_DRAIN = false; F f; float* ssq;
    __device__ __forceinline__ void operator()(const f32x4 (&acc)[2][2][4][2], const Unit& u, int wr, int wc, int fr, int fq) const {
        const int row0 = u.pm * BM + wr * 64 + fr, col0 = u.pn * BM + wc * 32 + 4 * fq;
#pragma unroll
        for (int ai = 0; ai < 2; ++ai)
#pragma unroll
            for (int m = 0; m < 4; ++m) { const int row = row0 + ai * HALF + m * 16; float s = 0.f;
#pragma unroll
                for (int bj = 0; bj < 2; ++bj)
#pragma unroll
                    for (int n = 0; n < 2; ++n) { float v[4];
#pragma unroll
                        for (int e = 0; e < 4; ++e) v[e] = acc[ai][bj][m][n][e];
                        s += f(row, col0 + bj * HALF + n * 16, v); }
                if (F::HAS_SSQ) { s += __shfl_xor(s, 16); s += __shfl_xor(s, 32); if (fq == 0) ssq[(size_t)row * 16 + (u.pn & 3) * 4 + wc] = s; } }
    }
};

template <class Epi, class Sched, bool ALIGN_EPI = false, bool SP2 = false>
__device__ __forceinline__ void gemm_phase(PG8_LAS unsigned char* lds, const Gemm g, const Sched& S, const Epi& E) {
    const int tid = threadIdx.x, wid = __builtin_amdgcn_readfirstlane(tid >> 6), lane = tid & 63, wr = wid >> 2, wc = wid & 3, fr = lane & 15, fq = lane >> 4;
    const int K = g.K, nt = K / BK;
    unsigned voffA[2], voffB[2];
#pragma unroll
    for (int i = 0; i < 2; ++i) { int R, C; stage_rc(tid * 16 + i * 8192, R, C); const int Rb = Epi::PERM ? ((R & ~31) + perm32(R & 31)) : R;
        voffA[i] = (unsigned)(R * K + C) * 2u; voffB[i] = (unsigned)(Rb * K + C) * 2u; }
    const size_t kstep = (size_t)(BK * 2);
    const size_t hstep = (size_t)HALF * K * 2;
    const size_t tstep = 2 * hstep;
    const unsigned ldsw = (unsigned)wid * 1024u;
    const int aoff = lds_byte(wr * 64 + fr, fq * 8), boff = lds_byte(wc * 32 + fr, fq * 8);
#define PG8_SA(b, h) (((b) * 2 + (h)) * HTB)
#define PG8_SB(b, h) ((4 + (b) * 2 + (h)) * HTB)
#define PG8_STAGE(bufoff, gbase, voff) do { _Pragma("unroll") for (int _i = 0; _i < 2; ++_i) \
        __builtin_amdgcn_global_load_lds((const unsigned*)((const char*)(gbase) + (voff)[_i]), (PG8_LAS unsigned*)(lds + (bufoff) + ldsw + _i * 8192), 16, 0, 0); } while (0)
#define PG8_LDA(dst, b, h) do { _Pragma("unroll") for (int m = 0; m < 4; ++m) _Pragma("unroll") for (int k = 0; k < 2; ++k) dst[m][k] = *(const PG8_LAS bf16x8*)(lds + PG8_SA(b, h) + aoff + m * 2048 + k * 1024); } while (0)
#define PG8_LDB(dst, b, h) do { _Pragma("unroll") for (int n = 0; n < 2; ++n) _Pragma("unroll") for (int k = 0; k < 2; ++k) dst[n][k] = *(const PG8_LAS bf16x8*)(lds + PG8_SB(b, h) + boff + n * 2048 + k * 1024); } while (0)
#define PG8_MMA(ai, bj, At, Bt) do { __builtin_amdgcn_s_setprio(1); _Pragma("unroll") for (int m = 0; m < 4; ++m) _Pragma("unroll") for (int n = 0; n < 2; ++n) _Pragma("unroll") for (int k = 0; k < 2; ++k) \
        acc[ai][bj][m][n] = __builtin_amdgcn_mfma_f32_16x16x32_bf16(Bt[n][k], At[m][k], acc[ai][bj][m][n], 0, 0, 0); __builtin_amdgcn_s_setprio(0); } while (0)
#define PG8_WAIT_V(n) asm volatile("s_waitcnt vmcnt(" #n ")" ::: "memory")
#define PG8_WAIT_L(n) asm volatile("s_waitcnt lgkmcnt(" #n ")" ::: "memory")
#define PG8_BAR __builtin_amdgcn_s_barrier()
#define PG8_SCHED __builtin_amdgcn_sched_barrier(0)
    Unit cur, nxt; int ui = 0;
    if (!S.next(0, cur)) return;
    f32x4 acc[2][2][4][2];
#pragma unroll
    for (int a = 0; a < 2; ++a)
#pragma unroll
        for (int b = 0; b < 2; ++b)
#pragma unroll
            for (int m = 0; m < 4; ++m)
#pragma unroll
                for (int n = 0; n < 2; ++n) acc[a][b][m][n] = (f32x4){0.f, 0.f, 0.f, 0.f};
    bf16x8 At[4][2], B0[2][2], B1[2][2];
    const char* cA = (const char*)g.A + (size_t)cur.pm * tstep; const char* cB = (const char*)g.Bt + (size_t)cur.pn * tstep;
    S.a_ready(cur);
    if constexpr (SP2) {
        PG8_STAGE(PG8_SB(0, 0), cB, voffB); PG8_STAGE(PG8_SB(0, 1), cB + hstep, voffB); PG8_STAGE(PG8_SA(0, 0), cA, voffA); PG8_STAGE(PG8_SA(0, 1), cA + hstep, voffA);
        if (wr == 1) PG8_BAR;
        PG8_WAIT_V(2); PG8_BAR;
        PG8_STAGE(PG8_SB(1, 0), cB + kstep, voffB); PG8_STAGE(PG8_SA(1, 0), cA + kstep, voffA); PG8_STAGE(PG8_SB(1, 1), cB + hstep + kstep, voffB);
        PG8_WAIT_V(6); PG8_BAR;
    } else {
        PG8_STAGE(PG8_SB(0, 0), cB, voffB); PG8_STAGE(PG8_SA(0, 0), cA, voffA); PG8_STAGE(PG8_SB(0, 1), cB + hstep, voffB); PG8_STAGE(PG8_SA(0, 1), cA + hstep, voffA);
        if (wr == 1) PG8_BAR;
        PG8_WAIT_V(4); PG8_BAR;
        PG8_STAGE(PG8_SB(1, 0), cB + kstep, voffB); PG8_STAGE(PG8_SA(1, 0), cA + kstep, voffA); PG8_STAGE(PG8_SB(1, 1), cB + hstep + kstep, voffB);
        PG8_WAIT_V(6); PG8_BAR;
    }
    for (;;) {
        const bool has_next = S.next(ui + 1, nxt);
        const char* nA = has_next ? (const char*)g.A + (size_t)nxt.pm * tstep : cA; const char* nB = has_next ? (const char*)g.Bt + (size_t)nxt.pn * tstep : cB;
        for (int t = 0; t < nt; t += 2) {
            const bool last = (t == nt - 2);
            const char* a1 = cA + (size_t)(t + 1) * kstep;
            const char* a2 = last ? nA : cA + (size_t)(t + 2) * kstep; const char* b2 = last ? nB : cB + (size_t)(t + 2) * kstep;
            const char* a3 = a2 + kstep; const char* b3 = b2 + kstep;
            if (last && has_next) S.a_ready(nxt);
            if constexpr (SP2) {
            PG8_LDB(B0, 0, 0); PG8_LDB(B1, 0, 1); PG8_SCHED; PG8_LDA(At, 0, 0); PG8_STAGE(PG8_SA(1, 1), a1 + hstep, voffA);
            PG8_WAIT_V(8); PG8_WAIT_L(0); PG8_BAR; PG8_MMA(0, 0, At, B0); PG8_MMA(0, 1, At, B1); PG8_BAR; PG8_SCHED;
            PG8_LDA(At, 0, 1); PG8_STAGE(PG8_SB(0, 0), b2, voffB); PG8_STAGE(PG8_SB(0, 1), b2 + hstep, voffB); PG8_STAGE(PG8_SA(0, 0), a2, voffA);
            PG8_WAIT_V(8); PG8_WAIT_L(0); PG8_BAR; PG8_MMA(1, 0, At, B0); PG8_MMA(1, 1, At, B1); PG8_BAR; PG8_SCHED;
            PG8_LDB(B0, 1, 0); PG8_LDB(B1, 1, 1); PG8_SCHED; PG8_LDA(At, 1, 0); PG8_STAGE(PG8_SA(0, 1), a2 + hstep, voffA);
            PG8_WAIT_V(8); PG8_WAIT_L(0); PG8_BAR; PG8_MMA(0, 0, At, B0); PG8_MMA(0, 1, At, B1); PG8_BAR; PG8_SCHED;
            PG8_LDA(At, 1, 1); PG8_STAGE(PG8_SB(1, 0), b3, voffB); PG8_STAGE(PG8_SB(1, 1), b3 + hstep, voffB); PG8_STAGE(PG8_SA(1, 0), a3, voffA);
            PG8_WAIT_V(8); PG8_WAIT_L(0); PG8_BAR; PG8_MMA(1, 0, At, B0); PG8_MMA(1, 1, At, B1); PG8_BAR; PG8_SCHED;
            } else {
            PG8_LDB(B0, 0, 0); PG8_SCHED; PG8_LDA(At, 0, 0); PG8_STAGE(PG8_SA(1, 1), a1 + hstep, voffA);
            PG8_WAIT_L(8); PG8_BAR; PG8_WAIT_L(0); PG8_MMA(0, 0, At, B0); PG8_BAR; PG8_SCHED;
            PG8_LDB(B1, 0, 1); PG8_STAGE(PG8_SB(0, 0), b2, voffB);
            PG8_BAR; PG8_WAIT_L(0); PG8_MMA(0, 1, At, B1); PG8_BAR;
            PG8_LDA(At, 0, 1); PG8_STAGE(PG8_SA(0, 0), a2, voffA);
            PG8_BAR; PG8_WAIT_L(0); PG8_MMA(1, 0, At, B0); PG8_BAR; PG8_SCHED;
            PG8_STAGE(PG8_SB(0, 1), b2 + hstep, voffB);
            PG8_WAIT_V(6); PG8_BAR; PG8_MMA(1, 1, At, B1); PG8_BAR;
            PG8_LDB(B0, 1, 0); PG8_SCHED; PG8_LDA(At, 1, 0); PG8_STAGE(PG8_SA(0, 1), a2 + hstep, voffA);
            PG8_WAIT_L(8); PG8_BAR; PG8_WAIT_L(0); PG8_MMA(0, 0, At, B0); PG8_BAR; PG8_SCHED;
            PG8_LDB(B1, 1, 1); PG8_STAGE(PG8_SB(1, 0), b3, voffB);
            PG8_BAR; PG8_WAIT_L(0); PG8_MMA(0, 1, At, B1); PG8_BAR;
            PG8_LDA(At, 1, 1); PG8_STAGE(PG8_SA(1, 0), a3, voffA);
            PG8_BAR; PG8_WAIT_L(0); PG8_MMA(1, 0, At, B0); PG8_BAR; PG8_SCHED;
            PG8_STAGE(PG8_SB(1, 1), b3 + hstep, voffB);
            PG8_WAIT_V(6); PG8_BAR; PG8_MMA(1, 1, At, B1); PG8_BAR;
            }
        }
        if constexpr (ALIGN_EPI) { if (wr == 0) PG8_BAR; }
        if constexpr (!Epi::AFTER_DRAIN) { E(acc, cur, wr, wc, fr, fq); S.done(cur); }
        if (!has_next) break;
#pragma unroll
        for (int a = 0; a < 2; ++a)
#pragma unroll
            for (int b = 0; b < 2; ++b)
#pragma unroll
                for (int m = 0; m < 4; ++m)
#pragma unroll
                    for (int n = 0; n < 2; ++n) acc[a][b][m][n] = (f32x4){0.f, 0.f, 0.f, 0.f};
        cur = nxt; cA = nA; cB = nB; ++ui;
        if constexpr (ALIGN_EPI) { if (wr == 1) PG8_BAR; }
    }
    PG8_WAIT_V(0);
    if constexpr (!ALIGN_EPI) { if (wr == 0) PG8_BAR; }
    PG8_BAR;
    if constexpr (Epi::AFTER_DRAIN) { E.fused(acc, cur, wr, wc, fr, fq, lds, wid, lane); S.done(cur); }
#undef PG8_SA
#undef PG8_SB
#undef PG8_STAGE
#undef PG8_LDA
#undef PG8_LDB
#undef PG8_MMA
#undef PG8_WAIT_V
#undef PG8_WAIT_L
#undef PG8_BAR
#undef PG8_SCHED
}
}

#include <hip/hip_bf16.h>
#include <cmath>
namespace attn_body {
using bf16=__hip_bfloat16;
using bf16x8=__attribute__((ext_vector_type(8)))short;
using s16x4=__attribute__((ext_vector_type(4)))short;
using f32x16=__attribute__((ext_vector_type(16)))float;
using u32x4=__attribute__((ext_vector_type(4)))unsigned;
constexpr int BATCH=32,NHEAD=16,SEQ=2048,D=64,DM=NHEAD*D;
constexpr int NW=8,QBLK=32,QB=QBLK*NW,KVBLK=64,NQB=SEQ/QB;
constexpr int ATTN_PITCH=DM, ATTN_UNIT_ROWS=QB;
__device__ __forceinline__ int crow(int r,int hi){return (r&3)+8*(r>>2)+4*hi;}
#define SBAR() __builtin_amdgcn_sched_barrier(0)
__device__ __forceinline__ void cmask(f32x16&p0,f32x16&p1,int jb,int qrel,int hi){
  const float NEG=-INFINITY; int kb=64*jb+4*hi;
  #pragma unroll
  for(int r=0;r<16;++r){int kv=kb+(r&3)+8*(r>>2); if(kv>qrel)p0[r]=NEG; if(kv+32>qrel)p1[r]=NEG;}
}

constexpr int NSLOT=3, SLOTB=8192;
constexpr int LDS_K=0, LDS_V=NSLOT*SLOTB, LDS_WS=2*NSLOT*SLOTB, LDS_OST=LDS_WS+NW*64*4, LDS_CUM=LDS_OST+NW*4096, LDS_BYTES=LDS_CUM+SEQ*4;
constexpr float C2=0.125f*1.4426950408889634f;
__device__ __forceinline__ void glds16(const void*gsrc,unsigned lds_dst){unsigned keep;
  asm volatile("s_mov_b32 %0, m0\n\ts_mov_b32 m0, %2\n\ts_nop 0\n\tglobal_load_lds_dwordx4 %1, off\n\ts_mov_b32 m0, %0":"=&s"(keep):"v"(gsrc),"s"(lds_dst):"memory");}
__device__ __forceinline__ float max3f(float a,float b,float c){float r;asm("v_max3_f32 %0, %1, %2, %3":"=v"(r):"v"(a),"v"(b),"v"(c));return r;}
__device__ __forceinline__ float max2f(float a,float b){float r;asm("v_max_f32_e32 %0, %1, %2":"=v"(r):"v"(a),"v"(b));return r;}
__device__ __forceinline__ float fadd_s(float a,float b){float r;asm("v_add_f32_e32 %0, %1, %2":"=v"(r):"v"(a),"v"(b));return r;}
__device__ __forceinline__ float fsub_s(float a,float b){float r;asm("v_sub_f32_e32 %0, %1, %2":"=v"(r):"v"(a),"v"(b));return r;}
typedef float f32x2_t __attribute__((ext_vector_type(2))); typedef __bf16 bf16x2_t __attribute__((ext_vector_type(2)));
__device__ __forceinline__ unsigned cvtpk_s(float lo,float hi){f32x2_t v={lo,hi};bf16x2_t b=__builtin_convertvector(v,bf16x2_t);return __builtin_bit_cast(unsigned,b);}
#define WAIT_BAR(N) asm volatile("s_waitcnt vmcnt(" #N ") lgkmcnt(0)\n\ts_barrier":::"memory")

__device__ __forceinline__ void qkt(f32x16&p0,f32x16&p1,const char*Kslot,const bf16x8*qr,int r32,int hi){
  const char*kb=Kslot+hi*1024+r32*16;
  #pragma unroll
  for(int d0=0;d0<4;++d0){
    const bf16x8 b0=*reinterpret_cast<const bf16x8*>(kb+d0*2048);
    const bf16x8 b1=*reinterpret_cast<const bf16x8*>(kb+d0*2048+512);
    p0=__builtin_amdgcn_mfma_f32_32x32x16_bf16(b0,qr[d0],p0,0,0,0);p1=__builtin_amdgcn_mfma_f32_32x32x16_bf16(b1,qr[d0],p1,0,0,0);}
}
typedef __attribute__((address_space(3))) const char* lds_cptr;
typedef short v4i16_t __attribute__((ext_vector_type(4)));
__device__ __forceinline__ void kload8(bf16x8*kf,lds_cptr kp){
  kf[0]=*(const __attribute__((address_space(3))) bf16x8*)(kp);      kf[1]=*(const __attribute__((address_space(3))) bf16x8*)(kp+512);
  kf[2]=*(const __attribute__((address_space(3))) bf16x8*)(kp+2048); kf[3]=*(const __attribute__((address_space(3))) bf16x8*)(kp+2560);
  kf[4]=*(const __attribute__((address_space(3))) bf16x8*)(kp+4096); kf[5]=*(const __attribute__((address_space(3))) bf16x8*)(kp+4608);
  kf[6]=*(const __attribute__((address_space(3))) bf16x8*)(kp+6144); kf[7]=*(const __attribute__((address_space(3))) bf16x8*)(kp+6656);
}
__device__ __forceinline__ void kload2(bf16x8*kf,lds_cptr kp,int j){ kf[2*j]=*(const __attribute__((address_space(3))) bf16x8*)(kp+j*2048); kf[2*j+1]=*(const __attribute__((address_space(3))) bf16x8*)(kp+j*2048+512); }
__device__ __forceinline__ s16x4 vtr(lds_cptr p){ return __builtin_bit_cast(s16x4,__builtin_amdgcn_ds_read_tr16_b64_v4i16((__attribute__((address_space(3))) v4i16_t*)p)); }
__device__ __forceinline__ float rowmax(const f32x16&p0,const f32x16&p1){
  float a=max3f(p0[0],p0[1],p1[0]),b=max3f(p0[2],p0[3],p1[1]);a=max3f(a,p1[2],p1[3]);
  #pragma unroll
  for(int r=4;r<16;r+=4){a=max3f(a,p0[r],p0[r+1]);b=max3f(b,p0[r+2],p0[r+3]);a=max3f(a,p1[r],p1[r+1]);b=max3f(b,p1[r+2],p1[r+3]);}
  const float m=max2f(a,b);
  auto rr=__builtin_amdgcn_permlane32_swap(__float_as_uint(m),__float_as_uint(m),false,false);
  return max2f(__uint_as_float(rr[0]),__uint_as_float(rr[1]));
}
__device__ __forceinline__ void pv(f32x16*o,int vb,bf16x8 pa0,bf16x8 pa1,bf16x8 pa2,bf16x8 pa3){
  #pragma unroll
  for(int d0=0;d0<2;++d0){s16x4 lo[4],hi[4];
    #pragma unroll
    for(int ks=0;ks<4;++ks){
      asm volatile("ds_read_b64_tr_b16 %0,%1 offset:%c2":"=&v"(lo[ks]):"v"(vb),"i"(d0*4096+ks*1024):"memory");
      asm volatile("ds_read_b64_tr_b16 %0,%1 offset:%c2":"=&v"(hi[ks]):"v"(vb),"i"(d0*4096+ks*1024+512):"memory");}
    asm volatile("s_waitcnt lgkmcnt(0)":::"memory");SBAR();
    #define PK(k) (bf16x8){lo[k][0],lo[k][1],lo[k][2],lo[k][3],hi[k][0],hi[k][1],hi[k][2],hi[k][3]}
    o[d0]=__builtin_amdgcn_mfma_f32_32x32x16_bf16(pa0,PK(0),o[d0],0,0,0);
    o[d0]=__builtin_amdgcn_mfma_f32_32x32x16_bf16(pa1,PK(1),o[d0],0,0,0);
    o[d0]=__builtin_amdgcn_mfma_f32_32x32x16_bf16(pa2,PK(2),o[d0],0,0,0);
    o[d0]=__builtin_amdgcn_mfma_f32_32x32x16_bf16(pa3,PK(3),o[d0],0,0,0);
    #undef PK
  }
}

#ifndef ATTN_STORE16
#define ATTN_STORE16(p,v) (*(u32x4*)(p)=(v))
#endif
template<int THRL> __device__ __forceinline__ void attn_unit(int b,int h,int qb,const bf16*Q,const bf16*__restrict__ K,const bf16*__restrict__ V,bf16*O,const bf16*__restrict__ Zg,const float*__restrict__ cumg,bool load_cum,char*shm){
  const int tid=threadIdx.x,lane=tid&63,r32=lane&31,hi=lane>>5; const int wid=__builtin_amdgcn_readfirstlane(tid>>6);
  const long rowbase=(long)b*SEQ; const int q0=qb*QB;
  const bf16*Qw=Q+(rowbase+q0+wid*QBLK)*DM+h*D;
  const bf16*Kh=K+rowbase*DM+h*D,*Vh=V+rowbase*DM+h*D;
  const unsigned lds0=(unsigned)(uintptr_t)shm;
  float*wsf=(float*)(shm+LDS_WS)+wid*64;
  typedef __attribute__((address_space(3))) float lds_f32; typedef float f32x4_t __attribute__((ext_vector_type(4)));
  typedef __attribute__((address_space(3))) f32x4_t lds_f32x4;
  lds_f32* const cumL=(lds_f32*)((__attribute__((address_space(3))) char*)shm+LDS_CUM);
  if(load_cum){ const f32x4_t cv=*(const f32x4_t*)(cumg+((long)(b*NHEAD+h)*SEQ)+tid*4); *(lds_f32x4*)(cumL+tid*4)=cv; }
  asm volatile("s_waitcnt vmcnt(0) lgkmcnt(0)\n\ts_barrier":::"memory");
  const bf16*ksrc=Kh+(long)lane*DM+wid*8;
  const bf16*vsrc=Vh+(long)(16*(wid&3)+(lane>>2))*DM+(wid>>2)*32+(lane&3)*8;
  const unsigned kdst=lds0+LDS_K+wid*1024, vdst=lds0+LDS_V+wid*1024;
  #define DMA_K(t,slot) glds16(ksrc+(long)(t)*KVBLK*DM,(unsigned)__builtin_amdgcn_readfirstlane(kdst+(slot)))
  #define DMA_V(t,slot) glds16(vsrc+(long)(t)*KVBLK*DM,(unsigned)__builtin_amdgcn_readfirstlane(vdst+(slot)))
  const int vb0=(int)(lds0+LDS_V)+((lane>>4)&1)*32+(lane&3)*8+(4*hi+((lane&15)>>2))*64;
  const char*Kbase=shm+LDS_K; bf16x8 kf[8];
  const lds_cptr shm3=(lds_cptr)shm; const lds_cptr kp0=shm3+LDS_K+hi*1024+r32*16; const lds_cptr vp0=shm3+LDS_V+((lane>>4)&1)*32+(lane&3)*8+(4*hi+((lane&15)>>2))*64;
  const int NT=(q0+QB)/KVBLK;
  DMA_K(0,0);DMA_V(0,0);DMA_K(1,SLOTB);
  bf16x8 qr[4];
  #pragma unroll
  for(int d0=0;d0<4;++d0)qr[d0]=*reinterpret_cast<const bf16x8*>(&Qw[(long)r32*DM+d0*16+hi*8]);
  const float cq=cumL[q0+wid*QBLK+r32];
  float mhat;
  { const bf16*Kd=Kh+(long)(q0+wid*QBLK+r32)*DM; float dsum=0.f;
    #pragma unroll
    for(int d0=0;d0<4;++d0){ const bf16x8 kk=*reinterpret_cast<const bf16x8*>(&Kd[d0*16+hi*8]);
      #pragma unroll
      for(int j=0;j<8;++j) dsum+=__uint_as_float(((unsigned)(unsigned short)qr[d0][j])<<16)*__uint_as_float(((unsigned)(unsigned short)kk[j])<<16); }
    auto rr=__builtin_amdgcn_permlane32_swap(__float_as_uint(dsum),__float_as_uint(dsum),false,false);
    mhat=__uint_as_float(rr[0])+__uint_as_float(rr[1]); }
  float l_reg=0.f;f32x16 o[2];o[0]=f32x16{};o[1]=f32x16{};
  #define CINIT(P0,P1,t) do{ const float u_=cq-mhat; const lds_f32x4* cp_=(const lds_f32x4*)(cumL+(t)*KVBLK+4*hi); \
    _Pragma("unroll") for(int g_=0;g_<4;++g_){ const f32x4_t c0_=cp_[2*g_], c1_=cp_[8+2*g_]; \
      _Pragma("unroll") for(int i_=0;i_<4;++i_){ P0[4*g_+i_]=u_-c0_[i_]; P1[4*g_+i_]=u_-c1_[i_]; } } }while(0)
  const int qrel=wid*QBLK+r32;
  #define CMASK(P0,P1,t) do{int jb_=(t)-(NT-4); if(jb_>=0)cmask(P0,P1,jb_,qrel,hi);}while(0)
  bool resc=false;
  #define START(P0,P1) do{ const float rm=rowmax(P0,P1); resc=false; \
    if(__any(rm>(float)THRL)){ const float dl=__builtin_fmaxf(rm,0.f); mhat=fadd_s(mhat,dl); \
      _Pragma("unroll") for(int r=0;r<16;++r){P0[r]=fsub_s(P0[r],dl);P1[r]=fsub_s(P1[r],dl);} } \
    _Pragma("unroll") for(int r=0;r<16;++r)P0[r]=__builtin_amdgcn_exp2f(P0[r]); }while(0)
  #define RESC() do{ if(resc){ asm volatile("s_waitcnt lgkmcnt(0)":::"memory"); \
      _Pragma("unroll") for(int d_=0;d_<2;++d_) _Pragma("unroll") for(int r=0;r<16;++r)o[d_][r]*=wsf[crow(r,hi)]; } }while(0)
  f32x16 pA0,pA1,pB0,pB1;
  int sl_prev=0,sl_cur=0,sl_next=SLOTB;
  #define ROT() do{sl_prev=sl_cur;sl_cur=sl_next;sl_next=(sl_next==(NSLOT-1)*SLOTB)?0:sl_next+SLOTB;}while(0)
  DMA_K(2,2*SLOTB);
  WAIT_BAR(3);
  CINIT(pA0,pA1,0);qkt(pA0,pA1,Kbase,qr,r32,hi);asm volatile("s_nop 15\n\ts_nop 7":"+v"(pA0),"+v"(pA1));CMASK(pA0,pA1,0);
  START(pA0,pA1);
  _Pragma("unroll") for(int r=0;r<16;++r)pA1[r]=__builtin_amdgcn_exp2f(pA1[r]);
  WAIT_BAR(0);
  DMA_K(3,0);DMA_V(1,SLOTB);
  ROT();
  kload8(kf,kp0+sl_cur);
  WAIT_BAR(2);
  s16x4 vlo[8],vhi[8]; u32x4 pw0,pw1,pw2,pw3;
  #define PKW(P,B) cvtpk_s(P[B],P[B+1])
  #define PAF(k) __builtin_bit_cast(bf16x8,pw##k)
  #define VFR(i) (bf16x8){vlo[i][0],vlo[i][1],vlo[i][2],vlo[i][3],vhi[i][0],vhi[i][1],vhi[i][2],vhi[i][3]}
  #define PIN(x) asm volatile("":"+v"(x))
  #define MX3(a,b,c) __builtin_fmaxf(__builtin_fmaxf((a),(b)),(c))
  #define GAPA(MF,A0,A1,A2,A3,W0,W1,PW) do{ MF; sacc+=A0; sacc+=A1; sacc+=A2; sacc+=A3; PIN(sacc); W0; W1; PIN(PW); SBAR(); }while(0)
  #define EX(v) __builtin_amdgcn_exp2f(v)
  #define GAPB(MF,X,B) do{ MF; X[B]=EX(X[B]); X[B+1]=EX(X[B+1]); X[B+2]=EX(X[B+2]); X[B+3]=EX(X[B+3]); PIN(X); SBAR(); }while(0)
  #define VRD(i) do{ vlo[i]=vtr(vp_+(((i)>>2)*4096+((i)&3)*1024)); vhi[i]=vtr(vp_+(((i)>>2)*4096+((i)&3)*1024+512)); }while(0)
  #define KRD(G,j) do{ if(G){ kload2(kf,kp0+sl_next,j); SBAR(); } }while(0)
  #define STEP(C0,C1,P0,P1,t,GK,GV,GL) do{ SBAR(); CINIT(C0,C1,t); SBAR(); \
    const lds_cptr vp_=vp0+sl_prev; \
    VRD(0); SBAR(); float sacc=(P0[0]+P0[1]); \
    GAPA(C0=__builtin_amdgcn_mfma_f32_32x32x16_bf16(kf[0],qr[0],C0,0,0,0), P0[2],P0[3],P0[4],P0[5],     pw0[0]=PKW(P0,0), pw0[1]=PKW(P0,2), pw0); \
    VRD(4); SBAR(); GAPA(C1=__builtin_amdgcn_mfma_f32_32x32x16_bf16(kf[1],qr[0],C1,0,0,0), P0[6],P0[7],P0[8],P0[9],     pw0[2]=PKW(P0,4), pw0[3]=PKW(P0,6), pw0); \
    VRD(1); SBAR(); GAPA(C0=__builtin_amdgcn_mfma_f32_32x32x16_bf16(kf[2],qr[1],C0,0,0,0),   P0[10],P0[11],P0[12],P0[13], pw1[0]=PKW(P0,8), pw1[1]=PKW(P0,10), pw1); \
    VRD(5); SBAR(); GAPA(C1=__builtin_amdgcn_mfma_f32_32x32x16_bf16(kf[3],qr[1],C1,0,0,0),   P0[14],P0[15],P1[0],P1[1],   pw1[2]=PKW(P0,12),pw1[3]=PKW(P0,14), pw1); \
    VRD(2); SBAR(); GAPA(C0=__builtin_amdgcn_mfma_f32_32x32x16_bf16(kf[4],qr[2],C0,0,0,0),   P1[2],P1[3],P1[4],P1[5],     pw2[0]=PKW(P1,0), pw2[1]=PKW(P1,2), pw2); \
    VRD(6); SBAR(); GAPA(C1=__builtin_amdgcn_mfma_f32_32x32x16_bf16(kf[5],qr[2],C1,0,0,0),   P1[6],P1[7],P1[8],P1[9],     pw2[2]=PKW(P1,4), pw2[3]=PKW(P1,6), pw2); \
    VRD(3); SBAR(); GAPA(C0=__builtin_amdgcn_mfma_f32_32x32x16_bf16(kf[6],qr[3],C0,0,0,0),   P1[10],P1[11],P1[12],P1[13], pw3[0]=PKW(P1,8), pw3[1]=PKW(P1,10), pw3); \
    VRD(7); SBAR(); GAPA(C1=__builtin_amdgcn_mfma_f32_32x32x16_bf16(kf[7],qr[3],C1,0,0,0),   P1[14],P1[15],0.f,0.f,       pw3[2]=PKW(P1,12),pw3[3]=PKW(P1,14), pw3); \
    l_reg+=sacc; \
    if(GK){DMA_K((t)+3,sl_cur);} if(GV){DMA_V((t)+1,sl_next);} \
    CMASK(C0,C1,t); \
    { float a=MX3(C0[0],C0[1],C1[0]),b=MX3(C0[2],C0[3],C1[1]); a=MX3(a,C1[2],C1[3]); \
      _Pragma("unroll") for(int r=4;r<16;r+=4){a=MX3(a,C0[r],C0[r+1]);b=MX3(b,C0[r+2],C0[r+3]);a=MX3(a,C1[r],C1[r+1]);b=MX3(b,C1[r+2],C1[r+3]);} \
      float rm=__builtin_fmaxf(a,b); { auto rr=__builtin_amdgcn_permlane32_swap(__float_as_uint(rm),__float_as_uint(rm),false,false); rm=__builtin_fmaxf(__uint_as_float(rr[0]),__uint_as_float(rr[1])); } \
      resc=false; \
      if(__builtin_expect(__any(rm>(float)THRL),0)){ const float dl=__builtin_fmaxf(rm,0.f); mhat+=dl; \
        _Pragma("unroll") for(int r=0;r<16;++r){C0[r]-=dl;C1[r]-=dl;} \
        const float f=__builtin_amdgcn_exp2f(-dl); l_reg*=f; if(hi==0)wsf[r32]=f; resc=true; } } \
    SBAR(); \
    GAPB(o[0]=__builtin_amdgcn_mfma_f32_32x32x16_bf16(PAF(0),VFR(0),o[0],0,0,0), C0,0); \
    GAPB(o[1]=__builtin_amdgcn_mfma_f32_32x32x16_bf16(PAF(0),VFR(4),o[1],0,0,0), C0,4); \
    KRD(GL,0); GAPB(o[0]=__builtin_amdgcn_mfma_f32_32x32x16_bf16(PAF(1),VFR(1),o[0],0,0,0), C0,8); \
    KRD(GL,1); GAPB(o[1]=__builtin_amdgcn_mfma_f32_32x32x16_bf16(PAF(1),VFR(5),o[1],0,0,0), C0,12); \
    KRD(GL,2); GAPB(o[0]=__builtin_amdgcn_mfma_f32_32x32x16_bf16(PAF(2),VFR(2),o[0],0,0,0), C1,0); \
    KRD(GL,3); GAPB(o[1]=__builtin_amdgcn_mfma_f32_32x32x16_bf16(PAF(2),VFR(6),o[1],0,0,0), C1,4); \
    GAPB(o[0]=__builtin_amdgcn_mfma_f32_32x32x16_bf16(PAF(3),VFR(3),o[0],0,0,0), C1,8); \
    GAPB(o[1]=__builtin_amdgcn_mfma_f32_32x32x16_bf16(PAF(3),VFR(7),o[1],0,0,0), C1,12); \
    }while(0)
  int t=1;
  #undef CMASK
  #define CMASK(P0,P1,t) do{}while(0)
  for(;t+5<NT;t+=2){
    STEP(pB0,pB1,pA0,pA1,t,true,true,true);     WAIT_BAR(2); RESC(); ROT();
    STEP(pA0,pA1,pB0,pB1,t+1,true,true,true);   WAIT_BAR(2); RESC(); ROT();
  }
  #undef CMASK
  #define CMASK(P0,P1,t) do{int jb_=(t)-(NT-4); if(jb_>=0)cmask(P0,P1,jb_,qrel,hi);}while(0)
  #define ENDW(tt) do{ if((tt)+3<NT){WAIT_BAR(2);} else if((tt)+2<NT){WAIT_BAR(1);} else {WAIT_BAR(0);} }while(0)
  for(;t+1<NT;t+=2){
    STEP(pB0,pB1,pA0,pA1,t,(t+3<NT),(t+1<NT),(t+1<NT));       ENDW(t);   RESC(); ROT();
    STEP(pA0,pA1,pB0,pB1,t+1,(t+4<NT),(t+2<NT),(t+2<NT));     ENDW(t+1); RESC(); ROT();
  }
  STEP(pB0,pB1,pA0,pA1,NT-1,false,false,false); RESC();
  { float sacc=pB0[0]+pB0[1]; _Pragma("unroll") for(int r=2;r<16;++r)sacc+=pB0[r]; _Pragma("unroll") for(int r=0;r<16;++r)sacc+=pB1[r]; l_reg+=sacc;
    pw0=(u32x4){PKW(pB0,0),PKW(pB0,2),PKW(pB0,4),PKW(pB0,6)};pw1=(u32x4){PKW(pB0,8),PKW(pB0,10),PKW(pB0,12),PKW(pB0,14)};pw2=(u32x4){PKW(pB1,0),PKW(pB1,2),PKW(pB1,4),PKW(pB1,6)};pw3=(u32x4){PKW(pB1,8),PKW(pB1,10),PKW(pB1,12),PKW(pB1,14)};
    SBAR(); pv(o,vb0+sl_cur,PAF(0),PAF(1),PAF(2),PAF(3)); }
  #undef PKW
  #undef PAF
  #undef VFR
  #undef PIN
  #undef MX3
  #undef GAPA
  #undef GAPB
  #undef EX
  #undef VRD
  #undef KRD
  #undef STEP
  #undef ENDW
  {auto rr=__builtin_amdgcn_permlane32_swap(__float_as_uint(l_reg),__float_as_uint(l_reg),false,false);l_reg=__uint_as_float(rr[0])+__uint_as_float(rr[1]);}
  if(hi==0)wsf[32+r32]=l_reg;asm volatile("s_waitcnt lgkmcnt(0)":::"memory");
  float rli[16];
  #pragma unroll
  for(int r=0;r<16;++r)rli[r]=__builtin_amdgcn_rcpf(wsf[32+crow(r,hi)]);
  bf16*Ow=O+(rowbase+q0+wid*QBLK)*DM+h*D; const bf16*Zw=Zg+(rowbase+q0+wid*QBLK)*DM+h*D;
  { bf16*stg=(bf16*)(shm+LDS_OST)+wid*2048;
    #pragma unroll
    for(int r=0;r<16;++r){const int orow=crow(r,hi);
      #pragma unroll
      for(int d0=0;d0<2;++d0)stg[orow*64+d0*32+r32]=__float2bfloat16(o[d0][r]*rli[r]);}
    asm volatile("s_waitcnt lgkmcnt(0)":::"memory");
    #pragma unroll
    for(int i=0;i<4;++i){const int row=i*8+(lane>>3),ch=lane&7; const u32x4 v=*(const u32x4*)(stg+row*64+ch*8); const u32x4 zz=*(const u32x4*)(Zw+(long)row*DM+ch*8); u32x4 w;
      #pragma unroll
      for(int e=0;e<4;++e){ const float o0=__uint_as_float(v[e]<<16),o1=__uint_as_float(v[e]&0xffff0000u),z0=__uint_as_float(zz[e]<<16),z1=__uint_as_float(zz[e]&0xffff0000u);
        const float g0=o0*z0*__builtin_amdgcn_rcpf(1.f+__builtin_amdgcn_exp2f(-1.4426950408889634f*z0)), g1=o1*z1*__builtin_amdgcn_rcpf(1.f+__builtin_amdgcn_exp2f(-1.4426950408889634f*z1)); w[e]=cvtpk_s(g0,g1); }
      ATTN_STORE16(Ow+(long)row*DM+ch*8,w);} }
  asm volatile("s_waitcnt lgkmcnt(0)\n\ts_barrier":::"memory");
  #undef DMA_K
  #undef DMA_V
  #undef CMASK
  #undef START
  #undef RESC
  #undef CINIT
  #undef ROT
}
constexpr int ATTN_LDS_BYTES=LDS_BYTES;
struct AttnTensors { const bf16* Q; const bf16* K; const bf16* V; bf16* O; const bf16* Z; const float* cum; };
struct AttnUnit { int bh; int qb; };
struct StaticOrder {
  int vcu,G;
  __device__ __forceinline__ explicit StaticOrder(int grid,int block):vcu((grid%8==0)?(block%8)*(grid/8)+block/8:block),G(grid){}
  __device__ __forceinline__ bool next(int i,AttnUnit&u)const{ const int j=vcu+(i>>3)*G; if(j>=BATCH*NHEAD)return false; u.bh=j; u.qb=NQB-1-(i&7); return true; }
  __device__ __forceinline__ void a_ready(const AttnUnit&)const{}
  __device__ __forceinline__ void done(const AttnUnit&)const{}
};
template<class Sched,int THRL=8> __device__ __forceinline__ void attn_phase(char*lds,const AttnTensors&T,const Sched&S){
  AttnUnit u;
  for(int i=0;S.next(i,u);++i){ S.a_ready(u); attn_unit<THRL>(u.bh/NHEAD,u.bh%NHEAD,u.qb,T.Q,T.K,T.V,T.O,T.Z,T.cum,(i&7)==0,lds); S.done(u); }
}
#undef SBAR
#undef WAIT_BAR
}

constexpr int NWAVES = 8;
constexpr int BATCH = 32, SEQ = 2048, DM = 1024, NH = 16, HD = 64, M = BATCH * SEQ, NIN0 = 4 * DM + NH, NIN0P = 4352, PLE = 256, NG = 64, NS = 64, GS = 16;
constexpr float RMS_EPS = 1e-6f, LOG2E = 1.4426950408889634f;
#ifndef PH_FAST
#define PH_FAST 0xDADA
#endif
constexpr size_t MiB = 1u << 20;
constexpr size_t WS_CTL = 0, CTL_ZERO_BYTES = 1 * MiB;
constexpr size_t WS_WIN0 = 2 * MiB, WS_WOUT0 = 11 * MiB, WS_WG0 = 13 * MiB, WS_WP0 = 15 * MiB, WS_WIN1 = 16 * MiB, WS_WGLU = 20 * MiB, WS_WOUT1 = 22 * MiB, WS_WG1 = 24 * MiB, WS_WP1 = 26 * MiB;
constexpr size_t WS_S5L = 27 * MiB, WS_S5BB = 27 * MiB + 256 * 1024, WS_S5B = 28 * MiB, WS_S5C = 28 * MiB + 256 * 1024;
constexpr size_t WS_HN = 32 * MiB, WS_Q = 160 * MiB, WS_K = 288 * MiB, WS_V = 416 * MiB, WS_Z = 544 * MiB;
constexpr size_t WS_PB = 672 * MiB;
constexpr size_t WS_LOGF = 736 * MiB, WS_SSQ = 740 * MiB, WS_X2 = 744 * MiB, WS_CUM = 1000 * MiB, WS_END = 1004 * MiB;
constexpr int CW_TMO = 0, CW_CODE = 1, CW_BAR = 4096;
constexpr int RING_OFF = 0, RING_BYTES = 131072;
constexpr int LDSCTL_OFF = RING_BYTES, MISC_OFF = LDSCTL_OFF + 320;
constexpr int LDS_BYTES = 147456;
static_assert(MISC_OFF + 128 <= LDS_BYTES, "LDS map");
#define GAS __attribute__((address_space(1)))
#define LAS __attribute__((address_space(3)))
typedef unsigned short bf16;
typedef unsigned v4u __attribute__((ext_vector_type(4)));
typedef float f32x4 __attribute__((ext_vector_type(4)));
typedef short bf16x8 __attribute__((ext_vector_type(8)));
typedef GAS unsigned gu32;
typedef GAS unsigned long long gu64;
#define RLX_AGENT __ATOMIC_RELAXED, __HIP_MEMORY_SCOPE_AGENT
#define LDS_WAIT() asm volatile("s_waitcnt lgkmcnt(0)" ::: "memory")
#define VM_WAIT() asm volatile("s_waitcnt vmcnt(0)" ::: "memory")
__device__ __forceinline__ unsigned long long rt() { return __builtin_amdgcn_s_memrealtime(); }
__device__ __forceinline__ unsigned f2bf(float f) { unsigned u = __builtin_bit_cast(unsigned, f); return (u + 0x7fffu + ((u >> 16) & 1u)) >> 16; }
__device__ __forceinline__ unsigned pk2(float lo, float hi) { return f2bf(lo) | (f2bf(hi) << 16); }

#define XB_TMO      128
#define XB_XCNT(j)  (256  + 64 * (j))
#define XB_XSUB(j)  (1280 + 64 * (j))
#define XB_XGEN(j)  (2304 + 64 * (j))
#define XB_TOP      3328
#define XB_TOPGEN   3392
#define XCD_BAR_WORDS 3456
#define XB_SPIN_CAP (1u << 18)

__device__ __forceinline__ unsigned xb_ld(unsigned* p)              { return __hip_atomic_load(p, __ATOMIC_RELAXED, __HIP_MEMORY_SCOPE_AGENT); }
__device__ __forceinline__ unsigned xb_add(unsigned* p, unsigned v) { return __hip_atomic_fetch_add(p, v, __ATOMIC_RELAXED, __HIP_MEMORY_SCOPE_AGENT); }
__device__ __forceinline__ unsigned xb_xcc_id() { return (unsigned)__builtin_amdgcn_s_getreg((3 << 11) | 20) & 0xFu; }
#define XB_SPIN(cond, bar) do { unsigned _sp = 0; while (cond) { __builtin_amdgcn_s_sleep(1); \
    if ((++_sp & 255u) == 0u) { if (xb_ld(&(bar)[XB_TMO])) break; if (_sp > XB_SPIN_CAP) { atomicAdd(&(bar)[XB_TMO], 1u); break; } } } } while (0)

struct XcdBarrier {
    unsigned* bar; unsigned x;
    volatile LAS unsigned* st;
};

__device__ __forceinline__ XcdBarrier xcd_barrier_post(unsigned* bar, volatile LAS unsigned* st) {
    XcdBarrier b; b.bar = bar; b.x = xb_xcc_id(); b.st = st;
    if (threadIdx.x == 0) (void)xb_add(&bar[XB_XCNT(b.x)], 1u);
    return b;
}
__device__ __forceinline__ void xcd_barrier_complete(unsigned* bar, unsigned x, unsigned& nloc, unsigned& nx) {
    const unsigned G = gridDim.x * gridDim.y * gridDim.z;
    unsigned sum, cnt, mine, sp = 0u;
    for (;;) {
        sum = 0u; cnt = 0u; mine = 0u;
#pragma unroll
        for (unsigned j = 0; j < 16; ++j) { const unsigned c = xb_ld(&bar[XB_XCNT(j)]); sum += c; cnt += (c > 0u) ? 1u : 0u; mine = (j == x) ? c : mine; }
        if (sum == G) break;
        __builtin_amdgcn_s_sleep(1);
        if ((++sp & 255u) == 0u) { if (xb_ld(&bar[XB_TMO])) break; if (sp > XB_SPIN_CAP) { atomicAdd(&bar[XB_TMO], 1u); break; } }
    }
    nloc = mine > 0u ? mine : 1u; nx = cnt > 0u ? cnt : 1u;
}

__device__ __forceinline__ void xcd_barrier(const XcdBarrier& b) {
    asm volatile("s_waitcnt vmcnt(0)" ::: "memory");
    __syncthreads();
    if (threadIdx.x == 0) {
        unsigned* bar = b.bar;
        __builtin_amdgcn_s_waitcnt(0);
        unsigned nloc = b.st[0], nx = b.st[1];
        if (nloc == 0u) { xcd_barrier_complete(bar, b.x, nloc, nx); b.st[0] = nloc; b.st[1] = nx; }
        const unsigned old = xb_add(&bar[XB_XSUB(b.x)], 1u);
        const unsigned gen = old / nloc;
        if (old + 1u == (gen + 1u) * nloc) {
            __builtin_amdgcn_fence(__ATOMIC_RELEASE, "agent");
            asm volatile("s_waitcnt vmcnt(0)" ::: "memory");
            const unsigned og = xb_add(&bar[XB_TOP], 1u);
            const unsigned tg = og / nx;
            if (og + 1u == (tg + 1u) * nx) xb_add(&bar[XB_TOPGEN], 1u);
            else XB_SPIN(xb_ld(&bar[XB_TOPGEN]) == tg, bar);
            __builtin_amdgcn_fence(__ATOMIC_ACQUIRE, "agent");
            xb_add(&bar[XB_XGEN(b.x)], 1u);
            asm volatile("s_waitcnt vmcnt(0)" ::: "memory");
        } else {
            XB_SPIN(xb_ld(&bar[XB_XGEN(b.x)]) == gen, bar);
            __builtin_amdgcn_fence(__ATOMIC_ACQUIRE, "agent");
            asm volatile("s_waitcnt vmcnt(0)" ::: "memory");
        }
    }
    __syncthreads();
}
__device__ __forceinline__ float bf2f(unsigned short b) { return __uint_as_float((unsigned)b << 16); }
__device__ __forceinline__ float lo_f(unsigned w) { return __uint_as_float(w << 16); }
__device__ __forceinline__ float hi_f(unsigned w) { return __uint_as_float(w & 0xffff0000u); }
__device__ __forceinline__ float sigm(float v) { return __builtin_amdgcn_rcpf(1.f + __builtin_amdgcn_exp2f(-LOG2E * v)); }
__device__ __forceinline__ float gelu_tanh(float v) { return v * sigm(1.5957691216057308f * (v + 0.044715f * v * v * v)); }
__device__ __forceinline__ float logsigm(float v) { return fminf(v, 0.f) - log1pf(expf(-fabsf(v))); }
__device__ __forceinline__ float wave_sum(float v) {
#pragma unroll
    for (int o = 1; o < 64; o <<= 1) v += __shfl_xor(v, o);
    return v;
}
__device__ __forceinline__ float wave_max(float v) {
#pragma unroll
    for (int o = 1; o < 64; o <<= 1) v = fmaxf(v, __shfl_xor(v, o));
    return v;
}
__device__ __forceinline__ void unpack8(const v4u w, float* f) { f[0] = lo_f(w.x); f[1] = hi_f(w.x); f[2] = lo_f(w.y); f[3] = hi_f(w.y); f[4] = lo_f(w.z); f[5] = hi_f(w.z); f[6] = lo_f(w.w); f[7] = hi_f(w.w); }
__device__ __forceinline__ v4u pack8(const float* f) { v4u o; o.x = pk2(f[0], f[1]); o.y = pk2(f[2], f[3]); o.z = pk2(f[4], f[5]); o.w = pk2(f[6], f[7]); return o; }

struct FInProj0 { static constexpr bool HAS_SSQ = false; bf16* base; size_t stride; const float* bfg; float* logf;
    __device__ __forceinline__ float operator()(int row, int col, const float* v) const {
        if (col < 4 * DM) { const int t = col >> 10; const float sc = (t == 0) ? attn_body::C2 : 1.f; float w[8];
#pragma unroll
            for (int e = 0; e < 8; ++e) w[e] = v[e] * sc;
            *(v4u*)(base + (size_t)t * stride + (size_t)row * DM + (col & (DM - 1))) = pack8(w); }
        else if (col < NIN0) { const int c = col - 4 * DM; f32x4 a, b2;
#pragma unroll
            for (int e = 0; e < 4; ++e) { a[e] = logsigm(v[e] + bfg[c + e]); b2[e] = logsigm(v[4 + e] + bfg[c + 4 + e]); }
            *(f32x4*)(logf + (size_t)row * NH + c) = a; *(f32x4*)(logf + (size_t)row * NH + c + 4) = b2; }
        return 0.f; }
};
template <bool SSQ> struct FStore8 { static constexpr bool HAS_SSQ = SSQ; bf16* base; size_t stride;
    __device__ __forceinline__ float operator()(int row, int col, const float* v) const {
        *(v4u*)(base + (size_t)(col >> 10) * stride + (size_t)row * DM + (col & (DM - 1))) = pack8(v);
        float s = 0.f;
        if (SSQ) {
#pragma unroll
            for (int e = 0; e < 8; ++e) s += v[e] * v[e]; }
        return s; }
};
struct FGlu { static constexpr bool HAS_SSQ = false; const bf16* g; const bf16* z; const float* bias; bf16* out;
    __device__ __forceinline__ float operator()(int row, int col, const float* v) const {
        const size_t off = (size_t)row * DM + col; float gf[8], zf[8], w[8]; unpack8(*(const v4u*)(g + off), gf); unpack8(*(const v4u*)(z + off), zf);
        const f32x4 b0 = *(const f32x4*)(bias + col), b1 = *(const f32x4*)(bias + col + 4);
#pragma unroll
        for (int e = 0; e < 8; ++e) { const float bb = e < 4 ? b0[e & 3] : b1[e & 3]; w[e] = gf[e] * sigm(v[e] + bb) * zf[e] * sigm(zf[e]); }
        *(v4u*)(out + off) = pack8(w); return 0.f; }
};
template <bool SSQ> struct FGate { static constexpr bool HAS_SSQ = SSQ; const float* xi; const bf16* pp; const float* bias; float* xo;
    __device__ __forceinline__ float operator()(int row, int col, const float* v) const {
        const size_t off = (size_t)row * DM + col; const f32x4 x = *(const f32x4*)(xi + off), b = *(const f32x4*)(bias + col); const unsigned long long pw = *(const unsigned long long*)(pp + off);
        const float p0 = lo_f((unsigned)pw), p1 = hi_f((unsigned)pw), p2 = lo_f((unsigned)(pw >> 32)), p3 = hi_f((unsigned)(pw >> 32));
        f32x4 o; o[0] = x[0] + p0 * sigm(v[0] + b[0]); o[1] = x[1] + p1 * sigm(v[1] + b[1]); o[2] = x[2] + p2 * sigm(v[2] + b[2]); o[3] = x[3] + p3 * sigm(v[3] + b[3]);
        *(f32x4*)(xo + off) = o;
        return SSQ ? (o[0] * o[0] + o[1] * o[1]) + (o[2] * o[2] + o[3] * o[3]) : 0.f; }
};

template <int NC, class F> __device__ __forceinline__ void naive_gemm(const bf16* A, const bf16* Bt, int Mr, int N, int K, const F& f, int gtid, int nthr) {
    const long total = (long)Mr * (N / NC);
    for (long idx = gtid; idx < total; idx += nthr) {
        const int cg = (int)(idx / Mr), r = (int)(idx % Mr);
        float acc[NC];
#pragma unroll
        for (int e = 0; e < NC; ++e) acc[e] = 0.f;
        const v4u* ap = (const v4u*)(A + (size_t)r * K);
        for (int k8 = 0; k8 < K / 8; ++k8) { float af[8]; unpack8(ap[k8], af);
#pragma unroll
            for (int e = 0; e < NC; ++e) { float bf_[8]; unpack8(*((const v4u*)(Bt + (size_t)(cg * NC + e) * K) + k8), bf_);
#pragma unroll
                for (int j = 0; j < 8; ++j) acc[e] += af[j] * bf_[j]; } }
        f(r, cg * NC, acc);
    }
}
__device__ __forceinline__ void naive_rowssq_bf16(const bf16* Y, float* ssq, int gw, int ngw, int lane) {
    for (int row = gw; row < M; row += ngw) { float f0[8], f1[8]; unpack8(((const v4u*)(Y + (size_t)row * DM))[lane], f0); unpack8(((const v4u*)(Y + (size_t)row * DM))[64 + lane], f1); float s = 0.f;
#pragma unroll
        for (int e = 0; e < 8; ++e) s += f0[e] * f0[e] + f1[e] * f1[e];
        s = wave_sum(s); if (lane < 16) ssq[(size_t)row * 16 + lane] = lane == 0 ? s : 0.f; }
}
__device__ __forceinline__ void naive_rowssq_f32(const float* X, float* ssq, int gw, int ngw, int lane) {
    for (int row = gw; row < M; row += ngw) { float s = 0.f;
#pragma unroll
        for (int j = 0; j < 4; ++j) { const f32x4 v = ((const f32x4*)(X + (size_t)row * DM))[64 * j + lane]; s += (v[0] * v[0] + v[1] * v[1]) + (v[2] * v[2] + v[3] * v[3]); }
        s = wave_sum(s); if (lane < 16) ssq[(size_t)row * 16 + lane] = lane == 0 ? s : 0.f; }
}
__device__ __forceinline__ void naive_attn(const bf16* Q, const bf16* Kb, const bf16* Vb, const bf16* Z, const float* cum, bf16* O, int gw, int ngw, int lane) {
    for (int rid = gw; rid < M * NH; rid += ngw) {
        const int h = rid & 15, bt = rid >> 4, b = bt >> 11, t = bt & (SEQ - 1);
        const v4u* qp = (const v4u*)(Q + (size_t)bt * DM + h * HD); float q[64];
#pragma unroll
        for (int c = 0; c < 8; ++c) unpack8(qp[c], q + 8 * c);
        const float* cm = cum + (size_t)(b * NH + h) * SEQ; const float cq = cm[t];
        float m = -INFINITY, l = 0.f, o = 0.f;
        for (int s0 = 0; s0 <= t; s0 += 64) {
            const int s = s0 + lane; const v4u* kp = (const v4u*)(Kb + (size_t)(b * SEQ + s) * DM + h * HD); float x = 0.f;
#pragma unroll
            for (int c = 0; c < 8; ++c) { float kf[8]; unpack8(kp[c], kf);
#pragma unroll
                for (int j = 0; j < 8; ++j) x += q[8 * c + j] * kf[j]; }
            x = x + cq - cm[s]; if (s > t) x = -INFINITY;
            const float mn = fmaxf(m, wave_max(x)), alpha = __builtin_amdgcn_exp2f(m - mn), p = __builtin_amdgcn_exp2f(x - mn);
            l = l * alpha + wave_sum(p); o *= alpha;
            const bf16* vp = Vb + (size_t)(b * SEQ + s0) * DM + h * HD + lane;
#pragma unroll 8
            for (int j = 0; j < 64; ++j) o += __shfl(p, j) * bf2f(vp[(size_t)j * DM]);
            m = mn;
        }
        const float z = bf2f(Z[(size_t)bt * DM + h * HD + lane]);
        O[(size_t)bt * DM + h * HD + lane] = (bf16)f2bf(o / l * z * sigm(z));
    }
}
__device__ __forceinline__ void naive_s5(const bf16* U, const float* S5L, const float* S5BB, const float* c_re, const float* c_im, const float* dsk, bf16* G, int gw, int ngw, int lane) {
    for (int unit = gw; unit < BATCH * NG; unit += ngw) {
        const int b = unit / NG, g = unit % NG, s = lane;
        const float are = S5L[(g * NS + s) * 2], aim = S5L[(g * NS + s) * 2 + 1];
        float bre[16], bim[16], cre[16], cim[16];
#pragma unroll
        for (int j = 0; j < 16; ++j) { bre[j] = S5BB[((size_t)(g * NS + s) * 16 + j) * 2]; bim[j] = S5BB[((size_t)(g * NS + s) * 16 + j) * 2 + 1]; cre[j] = c_re[(size_t)(g * GS + j) * NS + s]; cim[j] = c_im[(size_t)(g * GS + j) * NS + s]; }
        const float dd = dsk[g * GS + (lane & 15)];
        float xr = 0.f, xi = 0.f;
        for (int t = 0; t < SEQ; ++t) {
            const bf16* up = U + (size_t)(b * SEQ + t) * DM + g * GS; float uf[16]; unpack8(((const v4u*)up)[0], uf); unpack8(((const v4u*)up)[1], uf + 8);
            float br = 0.f, bi = 0.f;
#pragma unroll
            for (int j = 0; j < 16; ++j) { br += bre[j] * uf[j]; bi += bim[j] * uf[j]; }
            const float nr = are * xr - aim * xi + br, ni = are * xi + aim * xr + bi; xr = nr; xi = ni;
            float myy = 0.f;
#pragma unroll
            for (int i = 0; i < 16; ++i) { const float v = wave_sum(cre[i] * xr - cim[i] * xi); if (lane == i) myy = v; }
            if (lane < 16) G[(size_t)(b * SEQ + t) * DM + g * GS + lane] = (bf16)f2bf(gelu_tanh(myy + dd * bf2f(up[lane])));
        }
    }
}
__device__ __forceinline__ void p0_transpose_item(const float* W, int K, int ldw, int nvalid, int nblk, bf16* WT, LAS float* scr, int item, int lane) {
    const int kb = item / nblk, nb = item % nblk, k0 = 64 * kb, n0 = 32 * nb; const int nn = n0 + (lane & 31); const bool ok = nn < nvalid;
#pragma unroll 8
    for (int i = 0; i < 32; ++i) { const int kk = 2 * i + (lane >> 5); scr[kk * 33 + (lane & 31)] = ok ? W[(size_t)(k0 + kk) * ldw + nn] : 0.f; }
    LDS_WAIT(); asm volatile("" ::: "memory");
    const int c = lane & 7;
#pragma unroll
    for (int j = 0; j < 4; ++j) { const int n = (lane >> 3) + 8 * j; const LAS float* s = scr + (8 * c) * 33 + n;
        v4u o; o.x = pk2(s[0 * 33], s[1 * 33]); o.y = pk2(s[2 * 33], s[3 * 33]); o.z = pk2(s[4 * 33], s[5 * 33]); o.w = pk2(s[6 * 33], s[7 * 33]);
        *(GAS v4u*)(WT + (size_t)(n0 + n) * K + k0 + 8 * c) = o; }
    LDS_WAIT(); asm volatile("" ::: "memory");
}
__device__ __forceinline__ void rms_row_bf16(const float* xrow, const float* gain, bf16* orow, float tot, int lane) {
    const f32x4* xr = (const f32x4*)xrow; const f32x4* gr = (const f32x4*)gain;
    f32x4 v[4] = {xr[2 * lane], xr[2 * lane + 1], xr[128 + 2 * lane], xr[128 + 2 * lane + 1]};
    if (tot < 0.f) { float s = 0.f;
#pragma unroll
        for (int j = 0; j < 4; ++j) s += (v[j][0] * v[j][0] + v[j][1] * v[j][1]) + (v[j][2] * v[j][2] + v[j][3] * v[j][3]);
        tot = wave_sum(s); }
    const float rstd = 1.0f / sqrtf(tot * (1.0f / DM) + RMS_EPS);
    const f32x4 g[4] = {gr[2 * lane], gr[2 * lane + 1], gr[128 + 2 * lane], gr[128 + 2 * lane + 1]};
    float w[16];
#pragma unroll
    for (int j = 0; j < 4; ++j)
#pragma unroll
        for (int e = 0; e < 4; ++e) w[4 * j + e] = v[j][e] * rstd * g[j][e];
    ((v4u*)orow)[lane] = pack8(w); ((v4u*)orow)[64 + lane] = pack8(w + 8);
}
__device__ __forceinline__ float row_ssq_total(const float* ssq, int row, int lane) {
    float s = ssq[(size_t)row * 16 + (lane & 15)];
    s += __shfl_xor(s, 1); s += __shfl_xor(s, 2); s += __shfl_xor(s, 4); s += __shfl_xor(s, 8); return s;
}
__device__ __forceinline__ void resid_phase(const float* xi, const bf16* y, const float* ssq, const float* gain, float* xo, bf16* xb, int gw, int ngw, int lane) {
    for (int row = gw; row < M; row += ngw) {
        const float rstd = 1.0f / sqrtf(row_ssq_total(ssq, row, lane) * (1.0f / DM) + RMS_EPS);
        const f32x4* xr = (const f32x4*)(xi + (size_t)row * DM); const f32x4* gr = (const f32x4*)gain; f32x4* orow = (f32x4*)(xo + (size_t)row * DM);
        float yv[16]; unpack8(((const v4u*)(y + (size_t)row * DM))[lane], yv); unpack8(((const v4u*)(y + (size_t)row * DM))[64 + lane], yv + 8);
        float w[16];
#pragma unroll
        for (int j = 0; j < 4; ++j) { const int ci = (j >> 1) * 128 + 2 * lane + (j & 1); const f32x4 xv = xr[ci], gv = gr[ci]; f32x4 o;
#pragma unroll
            for (int e = 0; e < 4; ++e) { const float yy = yv[4 * j + e]; o[e] = xv[e] + yy * rstd * gv[e]; w[4 * j + e] = o[e]; }
            orow[ci] = o; }
        ((v4u*)(xb + (size_t)row * DM))[lane] = pack8(w); ((v4u*)(xb + (size_t)row * DM))[64 + lane] = pack8(w + 8);
    }
}
__device__ __forceinline__ void s5_coef(const float* lam_re, const float* lam_im, const float* log_dt, int g, int s, float& lbr, float& lbi, float& cr, float& ci) {
    const float lr = lam_re[g * NS + s], li = lam_im[g * NS + s], dt = expf(log_dt[g]);
    const float zr = lr * dt, th = li * dt, mag = expf(zr), sn = sinf(th), cs = cosf(th), sh = sinf(0.5f * th);
    lbr = mag * cs; lbi = mag * sn;
    const float nr = expm1f(zr) * cs - 2.f * sh * sh, ni = lbi, den = lr * lr + li * li;
    cr = (nr * lr + ni * li) / den; ci = (ni * lr - nr * li) / den;
}
struct Args { const float* in[22]; float* out; unsigned char* ws; int ph_lo, ph_hi; };
static_assert(sizeof(Args) == 24 * 8 + 8, "Args has no padding");
constexpr int N_PHASES = 16;
__global__ void __launch_bounds__(NWAVES * 64, 2) fwd_kernel(Args args) {
    extern __shared__ __attribute__((aligned(16))) unsigned char lds[];
    LAS unsigned char* const L = (LAS unsigned char*)lds;
    volatile LAS unsigned* const MISC = (volatile LAS unsigned*)(L + MISC_OFF);
    const int tid = threadIdx.x, lane = tid & 63, wave = __builtin_amdgcn_readfirstlane(tid >> 6);
    const int G = gridDim.x, bx = blockIdx.x;
    const int gw = bx * NWAVES + wave, ngw = G * NWAVES, gtid = bx * (NWAVES * 64) + tid, nthr = G * NWAVES * 64;
    unsigned char* const ws = args.ws;
    gu32* const ctl = (gu32*)(ws + WS_CTL);
    const float* const x = args.in[0]; const float* const pin = args.in[1]; const float* const ln_pre = args.in[2]; const float* const ln_post = args.in[3];
    const float* const fox_w_in = args.in[4]; const float* const fox_b_f = args.in[5]; const float* const fox_w_out = args.in[6]; const float* const s5_w_in = args.in[7];
    const float* const lam_re = args.in[8]; const float* const lam_im = args.in[9]; const float* const log_dt = args.in[10]; const float* const b_re = args.in[11]; const float* const b_im = args.in[12];
    const float* const c_re = args.in[13]; const float* const c_im = args.in[14]; const float* const s5_d = args.in[15]; const float* const w_glu = args.in[16]; const float* const b_glu = args.in[17];
    const float* const s5_w_out = args.in[18]; const float* const ple_w_proj = args.in[19]; const float* const ple_w_gate = args.in[20]; const float* const ple_b_gate = args.in[21];
    float* const out = args.out;
    bf16* const Win0 = (bf16*)(ws + WS_WIN0); bf16* const Wout0 = (bf16*)(ws + WS_WOUT0); bf16* const Wg0 = (bf16*)(ws + WS_WG0); bf16* const Wp0 = (bf16*)(ws + WS_WP0);
    bf16* const Win1 = (bf16*)(ws + WS_WIN1); bf16* const Wglu = (bf16*)(ws + WS_WGLU); bf16* const Wout1 = (bf16*)(ws + WS_WOUT1); bf16* const Wg1 = (bf16*)(ws + WS_WG1); bf16* const Wp1 = (bf16*)(ws + WS_WP1);
    float* const S5L = (float*)(ws + WS_S5L); float* const S5BB = (float*)(ws + WS_S5BB); bf16* const S5B = (bf16*)(ws + WS_S5B); bf16* const S5C = (bf16*)(ws + WS_S5C);
    bf16* const HN = (bf16*)(ws + WS_HN); bf16* const QB_ = (bf16*)(ws + WS_Q); bf16* const KB = (bf16*)(ws + WS_K); bf16* const VB = (bf16*)(ws + WS_V); bf16* const ZB = (bf16*)(ws + WS_Z);
    bf16* const PB = (bf16*)(ws + WS_PB); float* const LOGF = (float*)(ws + WS_LOGF); float* const SSQ = (float*)(ws + WS_SSQ); float* const X2 = (float*)(ws + WS_X2); float* const CUM = (float*)(ws + WS_CUM);
    constexpr size_t TSTRIDE = (WS_K - WS_Q) / 2;
    for (int u = tid; u < (LDS_BYTES - LDSCTL_OFF) / 4; u += NWAVES * 64) ((LAS unsigned*)(L + LDSCTL_OFF))[u] = 0u;
    __syncthreads();
    XcdBarrier bar = xcd_barrier_post((unsigned*)(ctl + CW_BAR), MISC + 8);
    const int lo = args.ph_lo, hi = args.ph_hi;
#define IN(k) (lo <= (k) && (k) < hi)
#define SEAM(k) do { if (IN(k) && IN((k) + 1)) xcd_barrier(bar); } while (0)
#define FAST(k) (((PH_FAST) >> (k)) & 1)
#define RUN_GEMM(k, NCV, EPI, FUNC, Aop, Bop, NN, KK, SSQP) do { \
        if (FAST(k)) { pg8::Gemm g_{(const pg8::bf16_t*)(Aop), (const pg8::bf16_t*)(Bop), M, (NN), (KK)}; pg8::StaticOrder S_; S_.init(M, (NN), G, bx); \
            const EPI<decltype(FUNC)> E_{(FUNC), (SSQP)}; pg8::gemm_phase<EPI<decltype(FUNC)>, pg8::StaticOrder, true, true>(L + RING_OFF, g_, S_, E_); } \
        else naive_gemm<NCV>((Aop), (Bop), M, (NN), (KK), (FUNC), gtid, nthr); } while (0)

    if (IN(0)) {
        LAS float* scr = (LAS float*)(L + RING_OFF + wave * 16384);
        constexpr int I_IN0 = (DM / 64) * (NIN0P / 32), I_SQ = (DM / 64) * (DM / 32), I_IN1 = (DM / 64) * (2 * DM / 32), I_P = (PLE / 64) * (DM / 32);
        constexpr int NITEMS = I_IN0 + 5 * I_SQ + I_IN1 + 2 * I_P;
        for (int it = gw; it < NITEMS; it += ngw) {
            int r = it;
            if (r < I_IN0) { p0_transpose_item(fox_w_in, DM, NIN0, NIN0, NIN0P / 32, Win0, scr, r, lane); continue; } r -= I_IN0;
            if (r < I_SQ) { p0_transpose_item(fox_w_out, DM, DM, DM, DM / 32, Wout0, scr, r, lane); continue; } r -= I_SQ;
            if (r < I_SQ) { p0_transpose_item(ple_w_gate, DM, DM, DM, DM / 32, Wg0, scr, r, lane); continue; } r -= I_SQ;
            if (r < I_SQ) { p0_transpose_item(ple_w_gate + (size_t)DM * DM, DM, DM, DM, DM / 32, Wg1, scr, r, lane); continue; } r -= I_SQ;
            if (r < I_SQ) { p0_transpose_item(w_glu, DM, DM, DM, DM / 32, Wglu, scr, r, lane); continue; } r -= I_SQ;
            if (r < I_SQ) { p0_transpose_item(s5_w_out, DM, DM, DM, DM / 32, Wout1, scr, r, lane); continue; } r -= I_SQ;
            if (r < I_IN1) { p0_transpose_item(s5_w_in, DM, 2 * DM, 2 * DM, 2 * DM / 32, Win1, scr, r, lane); continue; } r -= I_IN1;
            if (r < I_P) { p0_transpose_item(ple_w_proj, PLE, DM, DM, DM / 32, Wp0, scr, r, lane); continue; } r -= I_P;
            p0_transpose_item(ple_w_proj + (size_t)PLE * DM, PLE, DM, DM, DM / 32, Wp1, scr, r, lane);
        }
        for (int m = gw; m < M; m += ngw) rms_row_bf16(x + (size_t)m * DM, ln_pre, HN + (size_t)m * DM, -1.f, lane);
        for (long i = gtid; i < (long)2 * M * PLE / 8; i += nthr) { const f32x4 a = ((const f32x4*)pin)[2 * i], b2 = ((const f32x4*)pin)[2 * i + 1]; v4u o; o.x = pk2(a[0], a[1]); o.y = pk2(a[2], a[3]); o.z = pk2(b2[0], b2[1]); o.w = pk2(b2[2], b2[3]); ((v4u*)PB)[i] = o; }
        for (int i = gtid; i < NG * NS; i += nthr) { const int g = i / NS, s = i % NS; float lbr, lbi, cr, ci; s5_coef(lam_re, lam_im, log_dt, g, s, lbr, lbi, cr, ci);
            S5L[2 * i] = lbr; S5L[2 * i + 1] = lbi;
            for (int j = 0; j < GS; ++j) { const float br = b_re[(size_t)i * GS + j], bi = b_im[(size_t)i * GS + j]; S5BB[((size_t)i * GS + j) * 2] = cr * br - ci * bi; S5BB[((size_t)i * GS + j) * 2 + 1] = cr * bi + ci * br; } }
        for (int i = gtid; i < NG * 4 * 64; i += nthr) {
            const int g = i >> 8, q = (i >> 6) & 3, ln = i & 63, n = ln & 31, h = ln >> 5, s = 2 * n + (q >> 1); float lbr, lbi, cr, ci; s5_coef(lam_re, lam_im, log_dt, g, s, lbr, lbi, cr, ci); float w[8];
            _Pragma("unroll") for (int jj = 0; jj < 8; ++jj) { const int j = 8 * h + jj; const float br = b_re[(size_t)(g * NS + s) * GS + j], bi = b_im[(size_t)(g * NS + s) * GS + j]; w[jj] = (q & 1) ? (cr * bi + ci * br) : (cr * br - ci * bi); }
            ((v4u*)S5B)[i] = pack8(w); }
        for (int i = gtid; i < NG * 4 * 64; i += nthr) {
            const int g = i >> 8, ks = (i >> 6) & 3, ln = i & 63, ch = ln & 15, kq = ln >> 4; float w[8];
            _Pragma("unroll") for (int jj = 0; jj < 8; ++jj) { const int comp = 32 * ks + 8 * kq + jj, s = comp >> 1; w[jj] = (comp & 1) ? -c_im[(size_t)(g * GS + ch) * NS + s] : c_re[(size_t)(g * GS + ch) * NS + s]; }
            ((v4u*)S5C)[i] = pack8(w); }
        SEAM(0);
    }
    if (IN(1)) { FInProj0 f{QB_, TSTRIDE, fox_b_f, LOGF}; RUN_GEMM(1, 8, pg8::Epi8, f, HN, Win0, NIN0P, DM, nullptr); SEAM(1); }
    if (IN(2)) {
        for (int sq = gw; sq < BATCH * NH; sq += ngw) { const int b = sq >> 4, h = sq & 15; float v[32]; float run = 0.f;
#pragma unroll
            for (int i = 0; i < 32; ++i) { run += LOGF[(size_t)(b * SEQ + lane * 32 + i) * NH + h]; v[i] = run; }
            float incl = run;
#pragma unroll
            for (int o = 1; o < 64; o <<= 1) { const float t = __shfl_up(incl, o); if (lane >= o) incl += t; }
            const float base = incl - run;
#pragma unroll
            for (int i = 0; i < 32; i += 4) { f32x4 w; w[0] = (base + v[i]) * LOG2E; w[1] = (base + v[i + 1]) * LOG2E; w[2] = (base + v[i + 2]) * LOG2E; w[3] = (base + v[i + 3]) * LOG2E; *(f32x4*)(CUM + (size_t)sq * SEQ + lane * 32 + i) = w; } }
        SEAM(2);
    }
    if (IN(3)) {
        if (FAST(3)) { static_assert(attn_body::ATTN_LDS_BYTES <= RING_BYTES && attn_body::ATTN_PITCH == DM, "attention body geometry vs frame");
            const attn_body::AttnTensors AT{(const attn_body::bf16*)QB_, (const attn_body::bf16*)KB, (const attn_body::bf16*)VB, (attn_body::bf16*)QB_, (const attn_body::bf16*)ZB, CUM};
            const attn_body::StaticOrder S(G, bx); attn_body::attn_phase<attn_body::StaticOrder>((char*)lds + RING_OFF, AT, S); }
        else naive_attn(QB_, KB, VB, ZB, CUM, QB_, gw, ngw, lane);
        SEAM(3);
    }
    if (IN(4)) { FStore8<true> f{VB, 0}; RUN_GEMM(4, 8, pg8::Epi8, f, QB_, Wout0, DM, DM, SSQ); if (!FAST(4)) { xcd_barrier(bar); naive_rowssq_bf16(VB, SSQ, gw, ngw, lane); } SEAM(4); }
    if (IN(5)) { resid_phase(x, VB, SSQ, ln_post, out, HN, gw, ngw, lane); SEAM(5); }
    if (IN(6)) { FStore8<false> f{KB, 0}; RUN_GEMM(6, 8, pg8::Epi8, f, PB, Wp0, DM, PLE, nullptr); SEAM(6); }
    if (IN(7)) { FGate<true> f{out, KB, ple_b_gate, X2}; RUN_GEMM(7, 4, pg8::Epi4, f, HN, Wg0, DM, DM, SSQ); if (!FAST(7)) { xcd_barrier(bar); naive_rowssq_f32(X2, SSQ, gw, ngw, lane); } SEAM(7); }
    if (IN(8)) { for (int m = gw; m < M; m += ngw) rms_row_bf16(X2 + (size_t)m * DM, ln_pre + DM, HN + (size_t)m * DM, row_ssq_total(SSQ, m, lane), lane); SEAM(8); }
    if (IN(9)) { FStore8<false> f{QB_, TSTRIDE}; RUN_GEMM(9, 8, pg8::Epi8, f, HN, Win1, 2 * DM, DM, nullptr); SEAM(9); }
    if (IN(10)) { naive_s5(QB_, S5L, S5BB, c_re, c_im, s5_d, VB, gw, ngw, lane); SEAM(10); }
    if (IN(11)) { FGlu f{VB, KB, b_glu, ZB}; RUN_GEMM(11, 8, pg8::Epi8, f, VB, Wglu, DM, DM, nullptr); SEAM(11); }
    if (IN(12)) { FStore8<true> f{QB_, 0}; RUN_GEMM(12, 8, pg8::Epi8, f, ZB, Wout1, DM, DM, SSQ); if (!FAST(12)) { xcd_barrier(bar); naive_rowssq_bf16(QB_, SSQ, gw, ngw, lane); } SEAM(12); }
    if (IN(13)) { resid_phase(X2, QB_, SSQ, ln_post + DM, out, HN, gw, ngw, lane); SEAM(13); }
    if (IN(14)) { FStore8<false> f{KB, 0}; RUN_GEMM(14, 8, pg8::Epi8, f, PB + (size_t)M * PLE, Wp1, DM, PLE, nullptr); SEAM(14); }
    if (IN(15)) { FGate<false> f{out, KB, ple_b_gate + DM, out}; RUN_GEMM(15, 4, pg8::Epi4, f, HN, Wg1, DM, DM, nullptr); }
#undef IN
#undef SEAM
#undef FAST
#undef RUN_GEMM
}

extern "C" void kernel_launch(void* const* d_in, const int* in_sizes, int n_in, void* d_out, int out_size, void* d_ws, size_t ws_size, hipStream_t stream) {
    static int grid = 0;
    if (grid == 0) {
        if (n_in != 22 || in_sizes[0] != M * DM || out_size != M * DM || ws_size < WS_END) { fprintf(stderr, "kernel_launch: built for 22 inputs, x/out of %d floats, >= %zu bytes of workspace; got n_in %d, in0 %d, out %d, ws %zu; nothing launched\n", M * DM, (size_t)WS_END, n_in, n_in > 0 ? in_sizes[0] : -1, out_size, ws_size); grid = -1; return; }
        int dev = 0, cus = 0, per_cu = 0;
        if (hipGetDevice(&dev) != hipSuccess || hipDeviceGetAttribute(&cus, hipDeviceAttributeMultiprocessorCount, dev) != hipSuccess) { fprintf(stderr, "kernel_launch: hipGetDevice / hipDeviceGetAttribute failed\n"); grid = -1; return; }
        if (hipFuncSetAttribute((const void*)fwd_kernel, hipFuncAttributeMaxDynamicSharedMemorySize, LDS_BYTES) != hipSuccess) { fprintf(stderr, "kernel_launch: hipFuncSetAttribute failed\n"); grid = -1; return; }
        if (hipOccupancyMaxActiveBlocksPerMultiprocessor(&per_cu, (const void*)fwd_kernel, NWAVES * 64, LDS_BYTES) != hipSuccess || per_cu < 1) { fprintf(stderr, "kernel_launch: occupancy query reports %d workgroups per CU; nothing launched\n", per_cu); (void)hipGetLastError(); grid = -1; return; }
        grid = cus;
    }
    if (grid < 0) return;
    if (hipMemsetAsync((char*)d_ws + WS_CTL, 0, CTL_ZERO_BYTES, stream) != hipSuccess) { fprintf(stderr, "kernel_launch: hipMemsetAsync failed\n"); return; }
    Args a{};
    for (int i = 0; i < 22; ++i) a.in[i] = (const float*)d_in[i];
    a.out = (float*)d_out; a.ws = (unsigned char*)d_ws; a.ph_lo = 0; a.ph_hi = N_PHASES;
    hipLaunchKernelGGL(fwd_kernel, dim3(grid), dim3(NWAVES * 64), LDS_BYTES, stream, a);
    const hipError_t le = hipPeekAtLastError();
    if (le != hipSuccess) fprintf(stderr, "kernel_launch: launch failed: %s\n", hipGetErrorName(le));
}
```

```cpp
#include <hip/hip_runtime.h>
#include <hip/hip_bf16.h>
#include <cstdio>
#include <cstdint>
#include <cmath>
namespace pg8 {
#define PG8_LAS __attribute__((address_space(3)))
typedef unsigned short bf16_t;
typedef short bf16x8 __attribute__((ext_vector_type(8)));
typedef float f32x4 __attribute__((ext_vector_type(4)));
typedef unsigned u32x4 __attribute__((ext_vector_type(4)));
constexpr int BM = 256, BK = 64, HALF = 128, HTB = HALF * BK * 2  , STAGE_BYTES = 8 * HTB, NXCD = 8, WGM = 8;

__host__ __device__ __forceinline__ int lds_byte(int r, int c) { const int st = (r >> 4) * 2 + (c >> 5), rr = r & 15, cc = c & 31, ob = rr * 64 + cc * 2; return st * 1024 + (ob ^ (((ob >> 9) & 1) << 5)); }
__host__ __device__ __forceinline__ void stage_rc(int b, int& R, int& C) { const int st = b / 1024, sb = b % 1024, swz = sb ^ (((sb >> 9) & 1) << 5); R = (st >> 1) * 16 + swz / 64; C = (st & 1) * 32 + (swz % 64) / 2; }
__host__ __device__ __forceinline__ int perm32(int rho) { const int n = rho >> 4, i = rho & 15; return 8 * (i >> 2) + 4 * n + (i & 3); }

struct Unit { int pm, pn; };
struct Gemm { const bf16_t* A; const bf16_t* Bt; int M, N, K; };

struct StaticOrder {
    int nM, nN, nwg, G, c;
    __host__ __device__ void init(int M, int N, int G_, int c_) { nM = M / BM; nN = N / BM; nwg = nM * nN; G = G_; c = c_; }
    __host__ __device__ bool next(int i, Unit& u) const {
        const long L = (long)i * G + c; if (L >= nwg) return false;
        int wgid = (int)L; { const int q = nwg / NXCD, r = nwg % NXCD, xcd = wgid % NXCD, off = wgid / NXCD; wgid = (xcd < r ? xcd * (q + 1) : r * (q + 1) + (xcd - r) * q) + off; }
        const int nig = WGM * nN, gid = wgid / nig, fm = gid * WGM, gsz = (nM - fm) < WGM ? (nM - fm) : WGM;
        u.pm = fm + ((wgid % nig) % gsz); u.pn = (wgid % nig) / gsz; return true;
    }
    __device__ __forceinline__ void a_ready(const Unit&) const {}
    __device__ __forceinline__ void done(const Unit&) const {}
};

__device__ __forceinline__ unsigned cvt_pk_bf16(float lo, float hi) { unsigned r; asm volatile("v_cvt_pk_bf16_f32 %0, %1, %2" : "=v"(r) : "v"(lo), "v"(hi)); return r; }
typedef float f32x2 __attribute__((ext_vector_type(2)));
constexpr int EPI_STG_OFF = 131072 + 1024, EPI_STG_BYTES = 2 * 8192;
template <class F> struct Epi8 {
    static constexpr bool PERM = true, AFTER_DRAIN = false; F f; float* ssq;
    __device__ __forceinline__ void operator()(const f32x4 (&acc)[2][2][4][2], const Unit& u, int wr, int wc, int fr, int fq, PG8_LAS unsigned char* lds) const {
        int lane = fr + 16 * fq, w = wr * 4 + wc; asm volatile("" : "+v"(lane));
        PG8_LAS unsigned char* const stg = lds + EPI_STG_OFF;
        const int rw = 16 * wr + fr, cw = 4 * wc + fq, woff = rw * 256 + ((cw ^ (rw & 7)) << 4);
        const int rr = 4 * w + (lane >> 4), cr = lane & 15, roff = rr * 256 + ((cr ^ (rr & 7)) << 4);
        const int grow = u.pm * BM + 64 * (rr >> 4) + (rr & 15), gcol = u.pn * BM + 8 * cr;
        const float ps = f.prescale(u);
        float mx[2] = {0.f, 0.f}, s0 = 0.f;
        typename F::Pre pn = f.load(grow, gcol);
#pragma unroll
        for (int s = 0; s < 16; ++s) { const int ai = s >> 3, m = (s >> 1) & 3, bj = s & 1, row = grow + ai * HALF + m * 16, col = gcol + bj * HALF;
            { const f32x4 a0 = acc[ai][bj][m][0] * ps, a1 = acc[ai][bj][m][1] * ps; u32x4 pkd; pkd.x = cvt_pk_bf16(a0[0], a0[1]); pkd.y = cvt_pk_bf16(a0[2], a0[3]); pkd.z = cvt_pk_bf16(a1[0], a1[1]); pkd.w = cvt_pk_bf16(a1[2], a1[3]);
              *(PG8_LAS u32x4*)(stg + (s & 1) * 8192 + woff) = pkd; }
            const typename F::Pre pc = pn;
            if (s + 1 < 16) pn = f.load(grow + ((s + 1) >> 3) * HALF + (((s + 1) >> 1) & 3) * 16, gcol + ((s + 1) & 1) * HALF);
            asm volatile("s_waitcnt lgkmcnt(0)\n\ts_barrier" ::: "memory");
            const u32x4 wv = *(const PG8_LAS u32x4*)(stg + (s & 1) * 8192 + roff); float v[8];
            v[0] = __uint_as_float(wv.x << 16); v[1] = __uint_as_float(wv.x & 0xffff0000u); v[2] = __uint_as_float(wv.y << 16); v[3] = __uint_as_float(wv.y & 0xffff0000u);
            v[4] = __uint_as_float(wv.z << 16); v[5] = __uint_as_float(wv.z & 0xffff0000u); v[6] = __uint_as_float(wv.w << 16); v[7] = __uint_as_float(wv.w & 0xffff0000u);
            const float sr = f.apply(row, col, v, pc);
            if constexpr (F::HAS_SSQ) { float t = sr; t += __shfl_xor(t, 1); t += __shfl_xor(t, 2); t += __shfl_xor(t, 4); t += __shfl_xor(t, 8);
                if (bj == 0) s0 = t; else if (cr < 4) ssq[(size_t)row * 16 + (u.pn & 3) * 4 + cr] = cr == 0 ? s0 + t : 0.f; }
            if constexpr (F::HAS_NORM) { float t = sr; t += __shfl_xor(t, 1); t += __shfl_xor(t, 2); mx[bj] = fmaxf(mx[bj], t); }
        }
        if constexpr (F::HAS_NORM) {
#pragma unroll
            for (int bj = 0; bj < 2; ++bj) { float t = mx[bj]; t = fmaxf(t, __shfl_xor(t, 16)); t = fmaxf(t, __shfl_xor(t, 32));
                if ((lane & 0x33) == 0) f.norm_commit(u, bj, cr >> 2, t); } }
    }
};
template <class F> struct Epi4 {
    static constexpr bool PERM = false, AFTER_DRAIN = false; F f; float* ssq;
    __device__ __forceinline__ void operator()(const f32x4 (&acc)[2][2][4][2], const Unit& u, int wr, int wc, int fr, int fq) const {
        int row0 = u.pm * BM + wr * 64 + fr, col0 = u.pn * BM + wc * 32 + 4 * fq; asm volatile("" : "+v"(row0), "+v"(col0));
#pragma unroll
        for (int ai = 0; ai < 2; ++ai)
#pragma unroll
            for (int m = 0; m < 4; ++m) { const int row = row0 + ai * HALF + m * 16; float s = 0.f;
#pragma unroll
                for (int bj = 0; bj < 2; ++bj)
#pragma unroll
                    for (int n = 0; n < 2; ++n) { float v[4];
#pragma unroll
                        for (int e = 0; e < 4; ++e) v[e] = acc[ai][bj][m][n][e];
                        s += f(row, col0 + bj * HALF + n * 16, v); }
                if (F::HAS_SSQ) { s += __shfl_xor(s, 16); s += __shfl_xor(s, 32); if (fq == 0) ssq[(size_t)row * 16 + (u.pn & 3) * 4 + wc] = s; } }
    }
};

template <class Epi, class Sched, bool ALIGN_EPI = false, bool SP2 = false>
__device__ __forceinline__ void gemm_phase(PG8_LAS unsigned char* lds, const Gemm g, const Sched& S, const Epi& E) {
    int tid_ = threadIdx.x; asm volatile("" : "+v"(tid_));
    const int tid = tid_, wid = __builtin_amdgcn_readfirstlane(tid >> 6), lane = tid & 63, wr = wid >> 2, wc = wid & 3, fr = lane & 15, fq = lane >> 4;
    const int K = g.K, nt = K / BK;
    unsigned voffA[2], voffB[2];
#pragma unroll
    for (int i = 0; i < 2; ++i) { int R, C; stage_rc(tid * 16 + i * 8192, R, C); const int Rb = Epi::PERM ? ((R & ~31) + perm32(R & 31)) : R;
        voffA[i] = (unsigned)(R * K + C) * 2u; voffB[i] = (unsigned)(Rb * K + C) * 2u; }
    const size_t kstep = (size_t)(BK * 2);
    const size_t hstep = (size_t)HALF * K * 2;
    const size_t tstep = 2 * hstep;
    const unsigned ldsw = (unsigned)wid * 1024u;
    const int aoff = lds_byte(wr * 64 + fr, fq * 8), boff = lds_byte(wc * 32 + fr, fq * 8);
#define PG8_SA(b, h) (((b) * 2 + (h)) * HTB)
#define PG8_SB(b, h) ((4 + (b) * 2 + (h)) * HTB)
#define PG8_STAGE(bufoff, gbase, voff) do { _Pragma("unroll") for (int _i = 0; _i < 2; ++_i) \
        __builtin_amdgcn_global_load_lds((const unsigned*)((const char*)(gbase) + (voff)[_i]), (PG8_LAS unsigned*)(lds + (bufoff) + ldsw + _i * 8192), 16, 0, 0); } while (0)
#define PG8_LDA(dst, b, h) do { _Pragma("unroll") for (int m = 0; m < 4; ++m) _Pragma("unroll") for (int k = 0; k < 2; ++k) dst[m][k] = *(const PG8_LAS bf16x8*)(lds + PG8_SA(b, h) + aoff + m * 2048 + k * 1024); } while (0)
#define PG8_LDB(dst, b, h) do { _Pragma("unroll") for (int n = 0; n < 2; ++n) _Pragma("unroll") for (int k = 0; k < 2; ++k) dst[n][k] = *(const PG8_LAS bf16x8*)(lds + PG8_SB(b, h) + boff + n * 2048 + k * 1024); } while (0)
#define PG8_MMA(ai, bj, At, Bt) do { __builtin_amdgcn_s_setprio(1); _Pragma("unroll") for (int m = 0; m < 4; ++m) _Pragma("unroll") for (int n = 0; n < 2; ++n) _Pragma("unroll") for (int k = 0; k < 2; ++k) \
        acc[ai][bj][m][n] = __builtin_amdgcn_mfma_f32_16x16x32_bf16(Bt[n][k], At[m][k], acc[ai][bj][m][n], 0, 0, 0); __builtin_amdgcn_s_setprio(0); } while (0)
#define PG8_WAIT_V(n) asm volatile("s_waitcnt vmcnt(" #n ")" ::: "memory")
#define PG8_WAIT_L(n) asm volatile("s_waitcnt lgkmcnt(" #n ")" ::: "memory")
#define PG8_BAR __builtin_amdgcn_s_barrier()
#define PG8_SCHED __builtin_amdgcn_sched_barrier(0)
    Unit cur, nxt; int ui = 0;
    if (!S.next(0, cur)) return;
    f32x4 acc[2][2][4][2];
#pragma unroll
    for (int a = 0; a < 2; ++a)
#pragma unroll
        for (int b = 0; b < 2; ++b)
#pragma unroll
            for (int m = 0; m < 4; ++m)
#pragma unroll
                for (int n = 0; n < 2; ++n) acc[a][b][m][n] = (f32x4){0.f, 0.f, 0.f, 0.f};
    bf16x8 At[4][2], B0[2][2], B1[2][2];
    const char* cA = (const char*)g.A + (size_t)cur.pm * tstep; const char* cB = (const char*)g.Bt + (size_t)cur.pn * tstep;
    S.a_ready(cur);
    if constexpr (SP2) {
        PG8_STAGE(PG8_SB(0, 0), cB, voffB); PG8_STAGE(PG8_SB(0, 1), cB + hstep, voffB); PG8_STAGE(PG8_SA(0, 0), cA, voffA); PG8_STAGE(PG8_SA(0, 1), cA + hstep, voffA);
        if (wr == 1) PG8_BAR;
        PG8_WAIT_V(2); PG8_BAR;
        PG8_STAGE(PG8_SB(1, 0), cB + kstep, voffB); PG8_STAGE(PG8_SA(1, 0), cA + kstep, voffA); PG8_STAGE(PG8_SB(1, 1), cB + hstep + kstep, voffB);
        PG8_WAIT_V(6); PG8_BAR;
    } else {
        PG8_STAGE(PG8_SB(0, 0), cB, voffB); PG8_STAGE(PG8_SA(0, 0), cA, voffA); PG8_STAGE(PG8_SB(0, 1), cB + hstep, voffB); PG8_STAGE(PG8_SA(0, 1), cA + hstep, voffA);
        if (wr == 1) PG8_BAR;
        PG8_WAIT_V(4); PG8_BAR;
        PG8_STAGE(PG8_SB(1, 0), cB + kstep, voffB); PG8_STAGE(PG8_SA(1, 0), cA + kstep, voffA); PG8_STAGE(PG8_SB(1, 1), cB + hstep + kstep, voffB);
        PG8_WAIT_V(6); PG8_BAR;
    }
    for (;;) {
        const bool has_next = S.next(ui + 1, nxt);
        const char* nA = has_next ? (const char*)g.A + (size_t)nxt.pm * tstep : cA; const char* nB = has_next ? (const char*)g.Bt + (size_t)nxt.pn * tstep : cB;
        for (int t = 0; t < nt; t += 2) {
            const bool last = (t == nt - 2);
            const char* a1 = cA + (size_t)(t + 1) * kstep;
            const char* a2 = last ? nA : cA + (size_t)(t + 2) * kstep; const char* b2 = last ? nB : cB + (size_t)(t + 2) * kstep;
            const char* a3 = a2 + kstep; const char* b3 = b2 + kstep;
            if (last && has_next) S.a_ready(nxt);
            if constexpr (SP2) {
            PG8_LDB(B0, 0, 0); PG8_LDB(B1, 0, 1); PG8_SCHED; PG8_LDA(At, 0, 0); PG8_STAGE(PG8_SA(1, 1), a1 + hstep, voffA);
            PG8_WAIT_V(8); PG8_WAIT_L(0); PG8_BAR; PG8_MMA(0, 0, At, B0); PG8_MMA(0, 1, At, B1); PG8_BAR; PG8_SCHED;
            PG8_LDA(At, 0, 1); PG8_STAGE(PG8_SB(0, 0), b2, voffB); PG8_STAGE(PG8_SB(0, 1), b2 + hstep, voffB); PG8_STAGE(PG8_SA(0, 0), a2, voffA);
            PG8_WAIT_V(8); PG8_WAIT_L(0); PG8_BAR; PG8_MMA(1, 0, At, B0); PG8_MMA(1, 1, At, B1); PG8_BAR; PG8_SCHED;
            PG8_LDB(B0, 1, 0); PG8_LDB(B1, 1, 1); PG8_SCHED; PG8_LDA(At, 1, 0); PG8_STAGE(PG8_SA(0, 1), a2 + hstep, voffA);
            PG8_WAIT_V(8); PG8_WAIT_L(0); PG8_BAR; PG8_MMA(0, 0, At, B0); PG8_MMA(0, 1, At, B1); PG8_BAR; PG8_SCHED;
            PG8_LDA(At, 1, 1); PG8_STAGE(PG8_SB(1, 0), b3, voffB); PG8_STAGE(PG8_SB(1, 1), b3 + hstep, voffB); PG8_STAGE(PG8_SA(1, 0), a3, voffA);
            PG8_WAIT_V(8); PG8_WAIT_L(0); PG8_BAR; PG8_MMA(1, 0, At, B0); PG8_MMA(1, 1, At, B1); PG8_BAR; PG8_SCHED;
            } else {
            PG8_LDB(B0, 0, 0); PG8_SCHED; PG8_LDA(At, 0, 0); PG8_STAGE(PG8_SA(1, 1), a1 + hstep, voffA);
            PG8_WAIT_L(8); PG8_BAR; PG8_WAIT_L(0); PG8_MMA(0, 0, At, B0); PG8_BAR; PG8_SCHED;
            PG8_LDB(B1, 0, 1); PG8_STAGE(PG8_SB(0, 0), b2, voffB);
            PG8_BAR; PG8_WAIT_L(0); PG8_MMA(0, 1, At, B1); PG8_BAR;
            PG8_LDA(At, 0, 1); PG8_STAGE(PG8_SA(0, 0), a2, voffA);
            PG8_BAR; PG8_WAIT_L(0); PG8_MMA(1, 0, At, B0); PG8_BAR; PG8_SCHED;
            PG8_STAGE(PG8_SB(0, 1), b2 + hstep, voffB);
            PG8_WAIT_V(6); PG8_BAR; PG8_MMA(1, 1, At, B1); PG8_BAR;
            PG8_LDB(B0, 1, 0); PG8_SCHED; PG8_LDA(At, 1, 0); PG8_STAGE(PG8_SA(0, 1), a2 + hstep, voffA);
            PG8_WAIT_L(8); PG8_BAR; PG8_WAIT_L(0); PG8_MMA(0, 0, At, B0); PG8_BAR; PG8_SCHED;
            PG8_LDB(B1, 1, 1); PG8_STAGE(PG8_SB(1, 0), b3, voffB);
            PG8_BAR; PG8_WAIT_L(0); PG8_MMA(0, 1, At, B1); PG8_BAR;
            PG8_LDA(At, 1, 1); PG8_STAGE(PG8_SA(1, 0), a3, voffA);
            PG8_BAR; PG8_WAIT_L(0); PG8_MMA(1, 0, At, B0); PG8_BAR; PG8_SCHED;
            PG8_STAGE(PG8_SB(1, 1), b3 + hstep, voffB);
            PG8_WAIT_V(6); PG8_BAR; PG8_MMA(1, 1, At, B1); PG8_BAR;
            }
        }
        if constexpr (ALIGN_EPI) { if (wr == 0) PG8_BAR; }
        if constexpr (!Epi::AFTER_DRAIN) { E(acc, cur, wr, wc, fr, fq, lds); S.done(cur); }
        if (!has_next) break;
#pragma unroll
        for (int a = 0; a < 2; ++a)
#pragma unroll
            for (int b = 0; b < 2; ++b)
#pragma unroll
                for (int m = 0; m < 4; ++m)
#pragma unroll
                    for (int n = 0; n < 2; ++n) acc[a][b][m][n] = (f32x4){0.f, 0.f, 0.f, 0.f};
        cur = nxt; cA = nA; cB = nB; ++ui;
        if constexpr (ALIGN_EPI) { if (wr == 1) PG8_BAR; }
    }
    PG8_WAIT_V(0);
    if constexpr (!ALIGN_EPI) { if (wr == 0) PG8_BAR; }
    PG8_BAR;
    if constexpr (Epi::AFTER_DRAIN) { E.fused(acc, cur, wr, wc, fr, fq, lds, wid, lane); S.done(cur); }
#undef PG8_SA
#undef PG8_SB
#undef PG8_STAGE
#undef PG8_LDA
#undef PG8_LDB
#undef PG8_MMA
#undef PG8_WAIT_V
#undef PG8_WAIT_L
#undef PG8_BAR
#undef PG8_SCHED
}
}

#include <hip/hip_bf16.h>
#include <cmath>
namespace attn_body {
using bf16=__hip_bfloat16;
using bf16x8=__attribute__((ext_vector_type(8)))short;
using s16x4=__attribute__((ext_vector_type(4)))short;
using f32x16=__attribute__((ext_vector_type(16)))float;
using u32x4=__attribute__((ext_vector_type(4)))unsigned;
constexpr int BATCH=32,NHEAD=16,SEQ=2048,D=64,DM=NHEAD*D;
constexpr int NW=8,QBLK=32,QB=QBLK*NW,KVBLK=64,NQB=SEQ/QB;
constexpr int ATTN_PITCH=DM, ATTN_UNIT_ROWS=QB;
__device__ __forceinline__ int crow(int r,int hi){return (r&3)+8*(r>>2)+4*hi;}
#define SBAR() __builtin_amdgcn_sched_barrier(0)
__device__ __forceinline__ void cmask(f32x16&p0,f32x16&p1,int jb,int qrel,int hi){
  const float NEG=-INFINITY; int kb=64*jb+4*hi;
  #pragma unroll
  for(int r=0;r<16;++r){int kv=kb+(r&3)+8*(r>>2); if(kv>qrel)p0[r]=NEG; if(kv+32>qrel)p1[r]=NEG;}
}

constexpr int NSLOT=3, SLOTB=8192;
constexpr int LDS_K=0, LDS_V=NSLOT*SLOTB, LDS_WS=2*NSLOT*SLOTB, LDS_OST=LDS_WS+NW*64*4, LDS_CUM=LDS_OST+NW*4096, LDS_AB=LDS_CUM+SEQ*4, LDS_Z=LDS_AB+128, LDS_BYTES=LDS_Z+NW*4096;
constexpr float C2=0.125f*1.4426950408889634f;
__device__ __forceinline__ void glds16(const void*gsrc,unsigned lds_dst){unsigned keep;
  asm volatile("s_mov_b32 %0, m0\n\ts_mov_b32 m0, %2\n\ts_nop 0\n\tglobal_load_lds_dwordx4 %1, off\n\ts_mov_b32 m0, %0":"=&s"(keep):"v"(gsrc),"s"(lds_dst):"memory");}
__device__ __forceinline__ float max3f(float a,float b,float c){float r;asm("v_max3_f32 %0, %1, %2, %3":"=v"(r):"v"(a),"v"(b),"v"(c));return r;}
__device__ __forceinline__ float max2f(float a,float b){float r;asm("v_max_f32_e32 %0, %1, %2":"=v"(r):"v"(a),"v"(b));return r;}
__device__ __forceinline__ float fadd_s(float a,float b){float r;asm("v_add_f32_e32 %0, %1, %2":"=v"(r):"v"(a),"v"(b));return r;}
__device__ __forceinline__ float fsub_s(float a,float b){float r;asm("v_sub_f32_e32 %0, %1, %2":"=v"(r):"v"(a),"v"(b));return r;}
typedef float f32x2_t __attribute__((ext_vector_type(2))); typedef __bf16 bf16x2_t __attribute__((ext_vector_type(2)));
__device__ __forceinline__ unsigned cvtpk_s(float lo,float hi){f32x2_t v={lo,hi};bf16x2_t b=__builtin_convertvector(v,bf16x2_t);return __builtin_bit_cast(unsigned,b);}
#define WAIT_BAR(N) asm volatile("s_waitcnt vmcnt(" #N ") lgkmcnt(0)\n\ts_barrier":::"memory")

__device__ __forceinline__ void qkt(f32x16&p0,f32x16&p1,const char*Kslot,const bf16x8*qr,int r32,int hi){
  const char*kb=Kslot+hi*1024+r32*16;
  #pragma unroll
  for(int d0=0;d0<4;++d0){
    const bf16x8 b0=*reinterpret_cast<const bf16x8*>(kb+d0*2048);
    const bf16x8 b1=*reinterpret_cast<const bf16x8*>(kb+d0*2048+512);
    p0=__builtin_amdgcn_mfma_f32_32x32x16_bf16(b0,qr[d0],p0,0,0,0);p1=__builtin_amdgcn_mfma_f32_32x32x16_bf16(b1,qr[d0],p1,0,0,0);}
}
typedef __attribute__((address_space(3))) const char* lds_cptr;
typedef short v4i16_t __attribute__((ext_vector_type(4)));
__device__ __forceinline__ void kload8(bf16x8*kf,lds_cptr kp){
  kf[0]=*(const __attribute__((address_space(3))) bf16x8*)(kp);      kf[1]=*(const __attribute__((address_space(3))) bf16x8*)(kp+512);
  kf[2]=*(const __attribute__((address_space(3))) bf16x8*)(kp+2048); kf[3]=*(const __attribute__((address_space(3))) bf16x8*)(kp+2560);
  kf[4]=*(const __attribute__((address_space(3))) bf16x8*)(kp+4096); kf[5]=*(const __attribute__((address_space(3))) bf16x8*)(kp+4608);
  kf[6]=*(const __attribute__((address_space(3))) bf16x8*)(kp+6144); kf[7]=*(const __attribute__((address_space(3))) bf16x8*)(kp+6656);
}
__device__ __forceinline__ void kload2(bf16x8*kf,lds_cptr kp,int j){ kf[2*j]=*(const __attribute__((address_space(3))) bf16x8*)(kp+j*2048); kf[2*j+1]=*(const __attribute__((address_space(3))) bf16x8*)(kp+j*2048+512); }
__device__ __forceinline__ s16x4 vtr(lds_cptr p){ return __builtin_bit_cast(s16x4,__builtin_amdgcn_ds_read_tr16_b64_v4i16((__attribute__((address_space(3))) v4i16_t*)p)); }
__device__ __forceinline__ float rowmax(const f32x16&p0,const f32x16&p1){
  float a=max3f(p0[0],p0[1],p1[0]),b=max3f(p0[2],p0[3],p1[1]);a=max3f(a,p1[2],p1[3]);
  #pragma unroll
  for(int r=4;r<16;r+=4){a=max3f(a,p0[r],p0[r+1]);b=max3f(b,p0[r+2],p0[r+3]);a=max3f(a,p1[r],p1[r+1]);b=max3f(b,p1[r+2],p1[r+3]);}
  const float m=max2f(a,b);
  auto rr=__builtin_amdgcn_permlane32_swap(__float_as_uint(m),__float_as_uint(m),false,false);
  return max2f(__uint_as_float(rr[0]),__uint_as_float(rr[1]));
}
__device__ __forceinline__ void pv(f32x16*o,int vb,bf16x8 pa0,bf16x8 pa1,bf16x8 pa2,bf16x8 pa3){
  #pragma unroll
  for(int d0=0;d0<2;++d0){s16x4 lo[4],hi[4];
    #pragma unroll
    for(int ks=0;ks<4;++ks){
      asm volatile("ds_read_b64_tr_b16 %0,%1 offset:%c2":"=&v"(lo[ks]):"v"(vb),"i"(d0*4096+ks*1024):"memory");
      asm volatile("ds_read_b64_tr_b16 %0,%1 offset:%c2":"=&v"(hi[ks]):"v"(vb),"i"(d0*4096+ks*1024+512):"memory");}
    asm volatile("s_waitcnt lgkmcnt(0)":::"memory");SBAR();
    #define PK(k) (bf16x8){lo[k][0],lo[k][1],lo[k][2],lo[k][3],hi[k][0],hi[k][1],hi[k][2],hi[k][3]}
    o[d0]=__builtin_amdgcn_mfma_f32_32x32x16_bf16(pa0,PK(0),o[d0],0,0,0);
    o[d0]=__builtin_amdgcn_mfma_f32_32x32x16_bf16(pa1,PK(1),o[d0],0,0,0);
    o[d0]=__builtin_amdgcn_mfma_f32_32x32x16_bf16(pa2,PK(2),o[d0],0,0,0);
    o[d0]=__builtin_amdgcn_mfma_f32_32x32x16_bf16(pa3,PK(3),o[d0],0,0,0);
    #undef PK
  }
}

#ifndef ATTN_STORE16
#define ATTN_STORE16(p,v) (*(u32x4*)(p)=(v))
#endif
template<int THRL> __device__ __forceinline__ void attn_unit(int b,int h,int qb,const bf16*Q,const bf16*__restrict__ K,const bf16*__restrict__ V,bf16*O,const bf16*__restrict__ Zg,const float*__restrict__ cumg,const float*qng,const float*kng,bool load_cum,char*shm){
  int tid_=threadIdx.x; asm volatile("":"+v"(tid_));
  const int tid=tid_,lane=tid&63,r32=lane&31,hi=lane>>5; const int wid=__builtin_amdgcn_readfirstlane(tid>>6);
  const long rowbase=(long)b*SEQ; const int q0=qb*QB;
  const bf16*Qw=Q+(rowbase+q0+wid*QBLK)*DM+h*D;
  const bf16*Kh=K+rowbase*DM+h*D,*Vh=V+rowbase*DM+h*D;
  const unsigned lds0=(unsigned)(uintptr_t)shm;
  float*wsf=(float*)(shm+LDS_WS)+wid*64;
  typedef __attribute__((address_space(3))) float lds_f32; typedef float f32x4_t __attribute__((ext_vector_type(4)));
  typedef __attribute__((address_space(3))) f32x4_t lds_f32x4;
  lds_f32* const cumL=(lds_f32*)((__attribute__((address_space(3))) char*)shm+LDS_CUM);
  lds_f32* const abL=(lds_f32*)((__attribute__((address_space(3))) char*)shm+LDS_AB);
  if(load_cum){
    const float* lf=cumg+((long)b*SEQ+tid*4)*NHEAD+h; float c0=lf[0],c1=c0+lf[NHEAD],c2=c1+lf[2*NHEAD],c3=c2+lf[3*NHEAD]; float inc=c3;
    #pragma unroll
    for(int o_=1;o_<64;o_<<=1){ const float t_=__shfl_up(inc,o_); if(lane>=o_)inc+=t_; }
    lds_f32* const wtot=abL+8;
    if(lane==63)wtot[wid]=inc;
    float ab=-1.f;
    if(qng&&tid<8){ const int bh_=b*NHEAD+h; const float q2=qng[(bh_*2+0)*8+tid]+qng[(bh_*2+1)*8+tid], k2=kng[bh_*2+0]+kng[bh_*2+1]; ab=2.04f*sqrtf(q2*k2); }
    if(tid<8)abL[tid]=ab;
    asm volatile("s_waitcnt lgkmcnt(0)\n\ts_barrier":::"memory");
    { float base=inc-c3;
      #pragma unroll
      for(int w_=0;w_<NW;++w_) if(w_<wid) base+=wtot[w_];
      const float L2E=1.4426950408889634f; f32x4_t cv; cv[0]=(base+c0)*L2E; cv[1]=(base+c1)*L2E; cv[2]=(base+c2)*L2E; cv[3]=(base+c3)*L2E; *(lds_f32x4*)(cumL+tid*4)=cv; }
    asm volatile("s_waitcnt vmcnt(0) lgkmcnt(0)\n\ts_barrier":::"memory"); }
  int tstart=0;
  { const float ab=abL[qb];
    if(ab>=0.f){ const float A_=ab+cumL[q0]; const int nfull=(q0+QB)/KVBLK; const bool sk=(lane<nfull-4)&&(A_-cumL[(lane<32?lane:0)*KVBLK+KVBLK-1]<-150.f);
      const unsigned long long mk=__ballot(sk); tstart=__builtin_ctzll(~mk)&~1; } tstart=__builtin_amdgcn_readfirstlane(tstart); }
  lds_f32* const cumLs=cumL+tstart*KVBLK;
  const bf16*ksrc=Kh+(long)tstart*KVBLK*DM+(long)lane*DM+wid*8;
  const bf16*vsrc=Vh+(long)tstart*KVBLK*DM+(long)(16*(wid&3)+(lane>>2))*DM+(wid>>2)*32+(lane&3)*8;
  const unsigned kdst=lds0+LDS_K+wid*1024, vdst=lds0+LDS_V+wid*1024;
  #define DMA_K(t,slot) glds16(ksrc+(long)(t)*KVBLK*DM,(unsigned)__builtin_amdgcn_readfirstlane(kdst+(slot)))
  #define DMA_V(t,slot) glds16(vsrc+(long)(t)*KVBLK*DM,(unsigned)__builtin_amdgcn_readfirstlane(vdst+(slot)))
  const int vb0=(int)(lds0+LDS_V)+((lane>>4)&1)*32+(lane&3)*8+(4*hi+((lane&15)>>2))*64;
  const char*Kbase=shm+LDS_K; bf16x8 kf[8];
  const lds_cptr shm3=(lds_cptr)shm; const lds_cptr kp0=shm3+LDS_K+hi*1024+r32*16; const lds_cptr vp0=shm3+LDS_V+((lane>>4)&1)*32+(lane&3)*8+(4*hi+((lane&15)>>2))*64;
  const int NT=(q0+QB)/KVBLK-tstart;
  DMA_K(0,0);DMA_V(0,0);DMA_K(1,SLOTB);
  bf16x8 qr[4];
  #pragma unroll
  for(int d0=0;d0<4;++d0)qr[d0]=*reinterpret_cast<const bf16x8*>(&Qw[(long)r32*DM+d0*16+hi*8]);
  const float cq=cumL[q0+wid*QBLK+r32];
  float mhat;
  { const bf16*Kd=Kh+(long)(q0+wid*QBLK+r32)*DM; float dsum=0.f;
    #pragma unroll
    for(int d0=0;d0<4;++d0){ const bf16x8 kk=*reinterpret_cast<const bf16x8*>(&Kd[d0*16+hi*8]);
      #pragma unroll
      for(int j=0;j<8;++j) dsum+=__uint_as_float(((unsigned)(unsigned short)qr[d0][j])<<16)*__uint_as_float(((unsigned)(unsigned short)kk[j])<<16); }
    auto rr=__builtin_amdgcn_permlane32_swap(__float_as_uint(dsum),__float_as_uint(dsum),false,false);
    mhat=__uint_as_float(rr[0])+__uint_as_float(rr[1]); }
  float l_reg=0.f;f32x16 o[2];o[0]=f32x16{};o[1]=f32x16{};
  #define CINIT(P0,P1,t) do{ const float u_=cq-mhat; const lds_f32x4* cp_=(const lds_f32x4*)(cumLs+(t)*KVBLK+4*hi); \
    _Pragma("unroll") for(int g_=0;g_<4;++g_){ const f32x4_t c0_=cp_[2*g_], c1_=cp_[8+2*g_]; \
      _Pragma("unroll") for(int i_=0;i_<4;++i_){ P0[4*g_+i_]=u_-c0_[i_]; P1[4*g_+i_]=u_-c1_[i_]; } } }while(0)
  const int qrel=wid*QBLK+r32;
  #define CMASK(P0,P1,t) do{int jb_=(t)-(NT-4); if(jb_>=0)cmask(P0,P1,jb_,qrel,hi);}while(0)
  bool resc=false;
  #define START(P0,P1) do{ const float rm=rowmax(P0,P1); resc=false; \
    if(__any(rm>(float)THRL)){ const float dl=__builtin_fmaxf(rm,0.f); mhat=fadd_s(mhat,dl); \
      _Pragma("unroll") for(int r=0;r<16;++r){P0[r]=fsub_s(P0[r],dl);P1[r]=fsub_s(P1[r],dl);} } \
    _Pragma("unroll") for(int r=0;r<16;++r)P0[r]=__builtin_amdgcn_exp2f(P0[r]); }while(0)
  #define RESC() do{ if(resc){ asm volatile("s_waitcnt lgkmcnt(0)":::"memory"); \
      _Pragma("unroll") for(int d_=0;d_<2;++d_) _Pragma("unroll") for(int r=0;r<16;++r)o[d_][r]*=wsf[crow(r,hi)]; } }while(0)
  f32x16 pA0,pA1,pB0,pB1;
  int sl_prev=0,sl_cur=0,sl_next=SLOTB;
  #define ROT() do{sl_prev=sl_cur;sl_cur=sl_next;sl_next=(sl_next==(NSLOT-1)*SLOTB)?0:sl_next+SLOTB;}while(0)
  DMA_K(2,2*SLOTB);
  WAIT_BAR(3);
  CINIT(pA0,pA1,0);qkt(pA0,pA1,Kbase,qr,r32,hi);asm volatile("s_nop 15\n\ts_nop 7":"+v"(pA0),"+v"(pA1));CMASK(pA0,pA1,0);
  START(pA0,pA1);
  _Pragma("unroll") for(int r=0;r<16;++r)pA1[r]=__builtin_amdgcn_exp2f(pA1[r]);
  WAIT_BAR(0);
  DMA_K(3,0);DMA_V(1,SLOTB);
  ROT();
  kload8(kf,kp0+sl_cur);
  WAIT_BAR(2);
  const bf16*Zw=Zg+(rowbase+q0+wid*QBLK)*DM+h*D;
  { const unsigned zdst=lds0+LDS_Z+wid*4096; const bf16*zsrc=Zw+(long)(lane>>3)*DM+(lane&7)*8;
    #pragma unroll
    for(int i=0;i<4;++i)glds16(zsrc+(long)i*8*DM,(unsigned)__builtin_amdgcn_readfirstlane(zdst+i*1024)); }
  s16x4 vlo[8],vhi[8]; u32x4 pw0,pw1,pw2,pw3;
  #define PKW(P,B) cvtpk_s(P[B],P[B+1])
  #define PAF(k) __builtin_bit_cast(bf16x8,pw##k)
  #define VFR(i) (bf16x8){vlo[i][0],vlo[i][1],vlo[i][2],vlo[i][3],vhi[i][0],vhi[i][1],vhi[i][2],vhi[i][3]}
  #define PIN(x) asm volatile("":"+v"(x))
  #define MX3(a,b,c) __builtin_fmaxf(__builtin_fmaxf((a),(b)),(c))
  #define GAPA(MF,A0,A1,A2,A3,W0,W1,PW) do{ MF; sacc+=A0; sacc+=A1; sacc+=A2; sacc+=A3; PIN(sacc); W0; W1; PIN(PW); SBAR(); }while(0)
  #define EX(v) __builtin_amdgcn_exp2f(v)
  #define GAPB(MF,X,B) do{ MF; X[B]=EX(X[B]); X[B+1]=EX(X[B+1]); X[B+2]=EX(X[B+2]); X[B+3]=EX(X[B+3]); PIN(X); SBAR(); }while(0)
  #define VRD(i) do{ vlo[i]=vtr(vp_+(((i)>>2)*4096+((i)&3)*1024)); vhi[i]=vtr(vp_+(((i)>>2)*4096+((i)&3)*1024+512)); }while(0)
  #define KRD(G,j) do{ if(G){ kload2(kf,kp0+sl_next,j); SBAR(); } }while(0)
  #define STEP(C0,C1,P0,P1,t,GK,GV,GL) do{ SBAR(); CINIT(C0,C1,t); SBAR(); \
    const lds_cptr vp_=vp0+sl_prev; \
    VRD(0); SBAR(); float sacc=(P0[0]+P0[1]); \
    GAPA(C0=__builtin_amdgcn_mfma_f32_32x32x16_bf16(kf[0],qr[0],C0,0,0,0), P0[2],P0[3],P0[4],P0[5],     pw0[0]=PKW(P0,0), pw0[1]=PKW(P0,2), pw0); \
    VRD(4); SBAR(); GAPA(C1=__builtin_amdgcn_mfma_f32_32x32x16_bf16(kf[1],qr[0],C1,0,0,0), P0[6],P0[7],P0[8],P0[9],     pw0[2]=PKW(P0,4), pw0[3]=PKW(P0,6), pw0); \
    VRD(1); SBAR(); GAPA(C0=__builtin_amdgcn_mfma_f32_32x32x16_bf16(kf[2],qr[1],C0,0,0,0),   P0[10],P0[11],P0[12],P0[13], pw1[0]=PKW(P0,8), pw1[1]=PKW(P0,10), pw1); \
    VRD(5); SBAR(); GAPA(C1=__builtin_amdgcn_mfma_f32_32x32x16_bf16(kf[3],qr[1],C1,0,0,0),   P0[14],P0[15],P1[0],P1[1],   pw1[2]=PKW(P0,12),pw1[3]=PKW(P0,14), pw1); \
    VRD(2); SBAR(); GAPA(C0=__builtin_amdgcn_mfma_f32_32x32x16_bf16(kf[4],qr[2],C0,0,0,0),   P1[2],P1[3],P1[4],P1[5],     pw2[0]=PKW(P1,0), pw2[1]=PKW(P1,2), pw2); \
    VRD(6); SBAR(); GAPA(C1=__builtin_amdgcn_mfma_f32_32x32x16_bf16(kf[5],qr[2],C1,0,0,0),   P1[6],P1[7],P1[8],P1[9],     pw2[2]=PKW(P1,4), pw2[3]=PKW(P1,6), pw2); \
    VRD(3); SBAR(); GAPA(C0=__builtin_amdgcn_mfma_f32_32x32x16_bf16(kf[6],qr[3],C0,0,0,0),   P1[10],P1[11],P1[12],P1[13], pw3[0]=PKW(P1,8), pw3[1]=PKW(P1,10), pw3); \
    VRD(7); SBAR(); GAPA(C1=__builtin_amdgcn_mfma_f32_32x32x16_bf16(kf[7],qr[3],C1,0,0,0),   P1[14],P1[15],0.f,0.f,       pw3[2]=PKW(P1,12),pw3[3]=PKW(P1,14), pw3); \
    l_reg+=sacc; \
    if(GK){DMA_K((t)+3,sl_cur);} if(GV){DMA_V((t)+1,sl_next);} \
    CMASK(C0,C1,t); \
    { float a=MX3(C0[0],C0[1],C1[0]),b=MX3(C0[2],C0[3],C1[1]); a=MX3(a,C1[2],C1[3]); \
      _Pragma("unroll") for(int r=4;r<16;r+=4){a=MX3(a,C0[r],C0[r+1]);b=MX3(b,C0[r+2],C0[r+3]);a=MX3(a,C1[r],C1[r+1]);b=MX3(b,C1[r+2],C1[r+3]);} \
      float rm=__builtin_fmaxf(a,b); { auto rr=__builtin_amdgcn_permlane32_swap(__float_as_uint(rm),__float_as_uint(rm),false,false); rm=__builtin_fmaxf(__uint_as_float(rr[0]),__uint_as_float(rr[1])); } \
      resc=false; \
      if(__builtin_expect(__any(rm>(float)THRL),0)){ const float dl=__builtin_fmaxf(rm,0.f); mhat+=dl; \
        _Pragma("unroll") for(int r=0;r<16;++r){C0[r]-=dl;C1[r]-=dl;} \
        const float f=__builtin_amdgcn_exp2f(-dl); l_reg*=f; if(hi==0)wsf[r32]=f; resc=true; } } \
    SBAR(); \
    GAPB(o[0]=__builtin_amdgcn_mfma_f32_32x32x16_bf16(PAF(0),VFR(0),o[0],0,0,0), C0,0); \
    GAPB(o[1]=__builtin_amdgcn_mfma_f32_32x32x16_bf16(PAF(0),VFR(4),o[1],0,0,0), C0,4); \
    KRD(GL,0); GAPB(o[0]=__builtin_amdgcn_mfma_f32_32x32x16_bf16(PAF(1),VFR(1),o[0],0,0,0), C0,8); \
    KRD(GL,1); GAPB(o[1]=__builtin_amdgcn_mfma_f32_32x32x16_bf16(PAF(1),VFR(5),o[1],0,0,0), C0,12); \
    KRD(GL,2); GAPB(o[0]=__builtin_amdgcn_mfma_f32_32x32x16_bf16(PAF(2),VFR(2),o[0],0,0,0), C1,0); \
    KRD(GL,3); GAPB(o[1]=__builtin_amdgcn_mfma_f32_32x32x16_bf16(PAF(2),VFR(6),o[1],0,0,0), C1,4); \
    GAPB(o[0]=__builtin_amdgcn_mfma_f32_32x32x16_bf16(PAF(3),VFR(3),o[0],0,0,0), C1,8); \
    GAPB(o[1]=__builtin_amdgcn_mfma_f32_32x32x16_bf16(PAF(3),VFR(7),o[1],0,0,0), C1,12); \
    }while(0)
  int t=1;
  #undef CMASK
  #define CMASK(P0,P1,t) do{}while(0)
  for(;t+5<NT;t+=2){
    STEP(pB0,pB1,pA0,pA1,t,true,true,true);     WAIT_BAR(2); RESC(); ROT();
    STEP(pA0,pA1,pB0,pB1,t+1,true,true,true);   WAIT_BAR(2); RESC(); ROT();
  }
  #undef CMASK
  #define CMASK(P0,P1,t) do{int jb_=(t)-(NT-4); if(jb_>=0)cmask(P0,P1,jb_,qrel,hi);}while(0)
  #define ENDW(tt) do{ if((tt)+3<NT){WAIT_BAR(2);} else if((tt)+2<NT){WAIT_BAR(1);} else {WAIT_BAR(0);} }while(0)
  for(;t+1<NT;t+=2){
    STEP(pB0,pB1,pA0,pA1,t,(t+3<NT),(t+1<NT),(t+1<NT));       ENDW(t);   RESC(); ROT();
    STEP(pA0,pA1,pB0,pB1,t+1,(t+4<NT),(t+2<NT),(t+2<NT));     ENDW(t+1); RESC(); ROT();
  }
  STEP(pB0,pB1,pA0,pA1,NT-1,false,false,false); RESC();
  { float sacc=pB0[0]+pB0[1]; _Pragma("unroll") for(int r=2;r<16;++r)sacc+=pB0[r]; _Pragma("unroll") for(int r=0;r<16;++r)sacc+=pB1[r]; l_reg+=sacc;
    pw0=(u32x4){PKW(pB0,0),PKW(pB0,2),PKW(pB0,4),PKW(pB0,6)};pw1=(u32x4){PKW(pB0,8),PKW(pB0,10),PKW(pB0,12),PKW(pB0,14)};pw2=(u32x4){PKW(pB1,0),PKW(pB1,2),PKW(pB1,4),PKW(pB1,6)};pw3=(u32x4){PKW(pB1,8),PKW(pB1,10),PKW(pB1,12),PKW(pB1,14)};
    SBAR(); pv(o,vb0+sl_cur,PAF(0),PAF(1),PAF(2),PAF(3)); }
  #undef PKW
  #undef PAF
  #undef VFR
  #undef PIN
  #undef MX3
  #undef GAPA
  #undef GAPB
  #undef EX
  #undef VRD
  #undef KRD
  #undef STEP
  #undef ENDW
  {auto rr=__builtin_amdgcn_permlane32_swap(__float_as_uint(l_reg),__float_as_uint(l_reg),false,false);l_reg=__uint_as_float(rr[0])+__uint_as_float(rr[1]);}
  if(hi==0)wsf[32+r32]=l_reg;asm volatile("s_waitcnt lgkmcnt(0)":::"memory");
  float rli[16];
  #pragma unroll
  for(int r=0;r<16;++r)rli[r]=__builtin_amdgcn_rcpf(wsf[32+crow(r,hi)]);
  bf16*Ow=O+(rowbase+q0+wid*QBLK)*DM+h*D;
  { bf16*stg=(bf16*)(shm+LDS_OST)+wid*2048;
    #pragma unroll
    for(int r=0;r<16;++r){const int orow=crow(r,hi);
      #pragma unroll
      for(int d0=0;d0<2;++d0)stg[orow*64+d0*32+r32]=__float2bfloat16(o[d0][r]*rli[r]);}
    asm volatile("s_waitcnt lgkmcnt(0)":::"memory");
    #pragma unroll
    for(int i=0;i<4;++i){const int row=i*8+(lane>>3),ch=lane&7; const u32x4 v=*(const u32x4*)(stg+row*64+ch*8); const u32x4 zz=*(const u32x4*)(shm+LDS_Z+wid*4096+i*1024+lane*16); u32x4 w;
      #pragma unroll
      for(int e=0;e<4;++e){ const float o0=__uint_as_float(v[e]<<16),o1=__uint_as_float(v[e]&0xffff0000u),z0=__uint_as_float(zz[e]<<16),z1=__uint_as_float(zz[e]&0xffff0000u);
        const float g0=o0*z0*__builtin_amdgcn_rcpf(1.f+__builtin_amdgcn_exp2f(-1.4426950408889634f*z0)), g1=o1*z1*__builtin_amdgcn_rcpf(1.f+__builtin_amdgcn_exp2f(-1.4426950408889634f*z1)); w[e]=cvtpk_s(g0,g1); }
      ATTN_STORE16(Ow+(long)row*DM+ch*8,w);} }
  asm volatile("s_waitcnt lgkmcnt(0)\n\ts_barrier":::"memory");
  #undef DMA_K
  #undef DMA_V
  #undef CMASK
  #undef START
  #undef RESC
  #undef CINIT
  #undef ROT
}
constexpr int ATTN_LDS_BYTES=LDS_BYTES;
struct AttnTensors { const bf16* Q; const bf16* K; const bf16* V; bf16* O; const bf16* Z; const float* cum; const float* qn; const float* kn; };
struct AttnUnit { int bh; int qb; };
struct StaticOrder {
  int vcu,G; const int* perm;
  __device__ __forceinline__ StaticOrder(int grid,int block,const int*perm_):vcu((grid%8==0)?(block%8)*(grid/8)+block/8:block),G(grid),perm(perm_){}
  __device__ __forceinline__ bool next(int i,AttnUnit&u)const{
    if(G==BATCH*NHEAD/2){ if(i>=16)return false; const int b=vcu>>3,k=vcu&7; u.bh=b*NHEAD+perm[(i<8)?k:15-k]; u.qb=(NQB-1-(i&7)+k)&(NQB-1); return true; }
    const int j=vcu+(i>>3)*G; if(j>=BATCH*NHEAD)return false; u.bh=j; u.qb=NQB-1-(i&7); return true; }
  __device__ __forceinline__ void a_ready(const AttnUnit&)const{}
  __device__ __forceinline__ void done(const AttnUnit&)const{}
};
template<class Sched,int THRL=8> __device__ __forceinline__ void attn_phase(char*lds,const AttnTensors&T,const Sched&S){
  AttnUnit u;
  for(int i=0;S.next(i,u);++i){ S.a_ready(u); attn_unit<THRL>(u.bh/NHEAD,u.bh%NHEAD,u.qb,T.Q,T.K,T.V,T.O,T.Z,T.cum,T.qn,T.kn,(i&7)==0,lds); S.done(u); }
}
#undef SBAR
#undef WAIT_BAR
}

constexpr int NWAVES = 8;
constexpr int BATCH = 32, SEQ = 2048, DM = 1024, NH = 16, HD = 64, M = BATCH * SEQ, NIN0 = 4 * DM + NH, NIN0P = 4352, PLE = 256, NG = 64, NS = 64, GS = 16;
constexpr float RMS_EPS = 1e-6f, LOG2E = 1.4426950408889634f;
#ifndef PROBE_PHASE
#define PROBE_PHASE -1
#define PROBE_REPS 1
#endif
#ifndef ATT_THRL
#define ATT_THRL 8
#endif
#ifndef PH_FAST
#define PH_FAST 0xDEDA
#endif
constexpr size_t MiB = 1u << 20;
constexpr size_t WS_CTL = 0, CTL_ZERO_BYTES = 1 * MiB;
constexpr size_t WS_WIN0 = 2 * MiB, WS_WOUT0 = 11 * MiB, WS_WG0 = 13 * MiB, WS_WP0 = 15 * MiB, WS_WIN1 = 16 * MiB, WS_WGLU = 20 * MiB, WS_WOUT1 = 22 * MiB, WS_WG1 = 24 * MiB, WS_WP1 = 26 * MiB;
constexpr size_t WS_S5L = 27 * MiB, WS_S5BB = 27 * MiB + 256 * 1024, WS_S5B = 28 * MiB, WS_S5C = 28 * MiB + 256 * 1024;
constexpr size_t WS_HN = 32 * MiB, WS_Q = 160 * MiB, WS_K = 288 * MiB, WS_V = 416 * MiB, WS_Z = 544 * MiB;
constexpr size_t WS_PB = 672 * MiB;
constexpr size_t WS_LOGF = 736 * MiB, WS_SSQ = 740 * MiB, WS_X2 = 744 * MiB, WS_CUM = 1000 * MiB, WS_END = 1004 * MiB;
constexpr int CW_TMO = 0, CW_CODE = 1, CW_BAR = 4096, CW_GRP = 16384  , CW_QN = 65536, CW_KN = CW_QN + BATCH * NH * 2 * 8;
constexpr int RING_OFF = 0, RING_BYTES = 131072;
constexpr int LDSCTL_OFF = RING_BYTES, MISC_OFF = LDSCTL_OFF + 320;
constexpr int LDS_BYTES = 131072 + 1024 + 16384;
static_assert(MISC_OFF + 128 <= LDSCTL_OFF + 1024 && pg8::EPI_STG_OFF == LDSCTL_OFF + 1024 && pg8::EPI_STG_OFF + pg8::EPI_STG_BYTES <= LDS_BYTES, "LDS map");
#define GAS __attribute__((address_space(1)))
#define LAS __attribute__((address_space(3)))
typedef unsigned short bf16;
typedef unsigned v4u __attribute__((ext_vector_type(4)));
typedef float f32x4 __attribute__((ext_vector_type(4)));
typedef short bf16x8 __attribute__((ext_vector_type(8)));
typedef GAS unsigned gu32;
typedef GAS unsigned long long gu64;
#define RLX_AGENT __ATOMIC_RELAXED, __HIP_MEMORY_SCOPE_AGENT
#define LDS_WAIT() asm volatile("s_waitcnt lgkmcnt(0)" ::: "memory")
#define VM_WAIT() asm volatile("s_waitcnt vmcnt(0)" ::: "memory")
__device__ __forceinline__ unsigned long long rt() { return __builtin_amdgcn_s_memrealtime(); }
__device__ __forceinline__ unsigned f2bf(float f) { unsigned u = __builtin_bit_cast(unsigned, f); return (u + 0x7fffu + ((u >> 16) & 1u)) >> 16; }
__device__ __forceinline__ unsigned pk2(float lo, float hi) { return f2bf(lo) | (f2bf(hi) << 16); }

#define XB_TMO      128
#define XB_XCNT(j)  (256  + 64 * (j))
#define XB_XSUB(j)  (1280 + 64 * (j))
#define XB_XGEN(j)  (2304 + 64 * (j))
#define XB_TOP      3328
#define XB_TOPGEN   3392
#define XCD_BAR_WORDS 3456
#define XB_SPIN_CAP (1u << 18)

__device__ __forceinline__ unsigned xb_ld(unsigned* p)              { return __hip_atomic_load(p, __ATOMIC_RELAXED, __HIP_MEMORY_SCOPE_AGENT); }
__device__ __forceinline__ unsigned xb_add(unsigned* p, unsigned v) { return __hip_atomic_fetch_add(p, v, __ATOMIC_RELAXED, __HIP_MEMORY_SCOPE_AGENT); }
__device__ __forceinline__ unsigned xb_xcc_id() { return (unsigned)__builtin_amdgcn_s_getreg((3 << 11) | 20) & 0xFu; }
#define XB_SPIN(cond, bar) do { unsigned _sp = 0; while (cond) { __builtin_amdgcn_s_sleep(1); \
    if ((++_sp & 255u) == 0u) { if (xb_ld(&(bar)[XB_TMO])) break; if (_sp > XB_SPIN_CAP) { atomicAdd(&(bar)[XB_TMO], 1u); break; } } } } while (0)

struct XcdBarrier {
    unsigned* bar; unsigned x;
    volatile LAS unsigned* st;
};

__device__ __forceinline__ XcdBarrier xcd_barrier_post(unsigned* bar, volatile LAS unsigned* st) {
    XcdBarrier b; b.bar = bar; b.x = xb_xcc_id(); b.st = st;
    if (threadIdx.x == 0) (void)xb_add(&bar[XB_XCNT(b.x)], 1u);
    return b;
}
__device__ __forceinline__ void xcd_barrier_complete(unsigned* bar, unsigned x, unsigned& nloc, unsigned& nx) {
    const unsigned G = gridDim.x * gridDim.y * gridDim.z;
    unsigned sum, cnt, mine, sp = 0u;
    for (;;) {
        sum = 0u; cnt = 0u; mine = 0u;
#pragma unroll
        for (unsigned j = 0; j < 16; ++j) { const unsigned c = xb_ld(&bar[XB_XCNT(j)]); sum += c; cnt += (c > 0u) ? 1u : 0u; mine = (j == x) ? c : mine; }
        if (sum == G) break;
        __builtin_amdgcn_s_sleep(1);
        if ((++sp & 255u) == 0u) { if (xb_ld(&bar[XB_TMO])) break; if (sp > XB_SPIN_CAP) { atomicAdd(&bar[XB_TMO], 1u); break; } }
    }
    nloc = mine > 0u ? mine : 1u; nx = cnt > 0u ? cnt : 1u;
}

__device__ __forceinline__ void xcd_barrier(const XcdBarrier& b) {
    asm volatile("s_waitcnt vmcnt(0)" ::: "memory");
    __syncthreads();
    if (threadIdx.x == 0) {
        unsigned* bar = b.bar;
        __builtin_amdgcn_s_waitcnt(0);
        unsigned nloc = b.st[0], nx = b.st[1];
        if (nloc == 0u) { xcd_barrier_complete(bar, b.x, nloc, nx); b.st[0] = nloc; b.st[1] = nx; }
        const unsigned old = xb_add(&bar[XB_XSUB(b.x)], 1u);
        const unsigned gen = old / nloc;
        if (old + 1u == (gen + 1u) * nloc) {
            __builtin_amdgcn_fence(__ATOMIC_RELEASE, "agent");
            asm volatile("s_waitcnt vmcnt(0)" ::: "memory");
            const unsigned og = xb_add(&bar[XB_TOP], 1u);
            const unsigned tg = og / nx;
            if (og + 1u == (tg + 1u) * nx) xb_add(&bar[XB_TOPGEN], 1u);
            else XB_SPIN(xb_ld(&bar[XB_TOPGEN]) == tg, bar);
            __builtin_amdgcn_fence(__ATOMIC_ACQUIRE, "agent");
            xb_add(&bar[XB_XGEN(b.x)], 1u);
            asm volatile("s_waitcnt vmcnt(0)" ::: "memory");
        } else {
            XB_SPIN(xb_ld(&bar[XB_XGEN(b.x)]) == gen, bar);
            __builtin_amdgcn_fence(__ATOMIC_ACQUIRE, "agent");
            asm volatile("s_waitcnt vmcnt(0)" ::: "memory");
        }
    }
    __syncthreads();
}
__device__ __forceinline__ float bf2f(unsigned short b) { return __uint_as_float((unsigned)b << 16); }
__device__ __forceinline__ float lo_f(unsigned w) { return __uint_as_float(w << 16); }
__device__ __forceinline__ float hi_f(unsigned w) { return __uint_as_float(w & 0xffff0000u); }
__device__ __forceinline__ float sigm(float v) { return __builtin_amdgcn_rcpf(1.f + __builtin_amdgcn_exp2f(-LOG2E * v)); }
__device__ __forceinline__ float gelu_tanh(float v) { return v * sigm(1.5957691216057308f * (v + 0.044715f * v * v * v)); }
__device__ __forceinline__ float logsigm(float v) { return fminf(v, 0.f) - 0.6931471805599453f * __builtin_amdgcn_logf(1.f + __builtin_amdgcn_exp2f(-LOG2E * fabsf(v))); }
__device__ __forceinline__ float wave_sum(float v) {
#pragma unroll
    for (int o = 1; o < 64; o <<= 1) v += __shfl_xor(v, o);
    return v;
}
__device__ __forceinline__ float wave_max(float v) {
#pragma unroll
    for (int o = 1; o < 64; o <<= 1) v = fmaxf(v, __shfl_xor(v, o));
    return v;
}
__device__ __forceinline__ void unpack8(const v4u w, float* f) { f[0] = lo_f(w.x); f[1] = hi_f(w.x); f[2] = lo_f(w.y); f[3] = hi_f(w.y); f[4] = lo_f(w.z); f[5] = hi_f(w.z); f[6] = lo_f(w.w); f[7] = hi_f(w.w); }
__device__ __forceinline__ v4u pack8(const float* f) { v4u o; o.x = pk2(f[0], f[1]); o.y = pk2(f[2], f[3]); o.z = pk2(f[4], f[5]); o.w = pk2(f[6], f[7]); return o; }

struct FInProj0 { static constexpr bool HAS_SSQ = false, HAS_NORM = true; bf16* base; size_t stride; const float* bfg; float* logf; unsigned* qn; unsigned* kn;
    __device__ __forceinline__ void norm_commit(const pg8::Unit& u, int bj, int wc, float v) const { if (u.pn >= 8) return; const int head = (u.pn & 3) * 4 + 2 * bj + (wc >> 1), half = wc & 1, b = u.pm >> 3, qb = u.pm & 7;
        unsigned* p = u.pn < 4 ? qn + ((size_t)((b * NH + head) * 2 + half)) * 8 + qb : kn + (size_t)((b * NH + head) * 2 + half); atomicMax(p, __float_as_uint(v)); }
    struct Pre {}; __device__ __forceinline__ Pre load(int, int) const { return Pre{}; }
    __device__ __forceinline__ float prescale(const pg8::Unit& u) const { return u.pn < 4 ? attn_body::C2 : 1.f; }
    __device__ __forceinline__ float operator()(int row, int col, const float* v) const { float w[8]; const float sc = col < DM ? attn_body::C2 : 1.f;
#pragma unroll
        for (int e = 0; e < 8; ++e) w[e] = v[e] * sc;
        return apply(row, col, w, Pre{}); }
    __device__ __forceinline__ float apply(int row, int col, const float* v, const Pre&) const {
        if (col < 4 * DM) { const int t = col >> 10; const float sc = 1.f; float w[8];
#pragma unroll
            for (int e = 0; e < 8; ++e) w[e] = v[e] * sc;
            *(v4u*)(base + (size_t)t * stride + (size_t)row * DM + (col & (DM - 1))) = pack8(w);
            if (t < 2) { float s = 0.f;
#pragma unroll
                for (int e = 0; e < 8; ++e) s += w[e] * w[e];
                return s; } }
        else if (col < NIN0) { const int c = col - 4 * DM; f32x4 a, b2;
#pragma unroll
            for (int e = 0; e < 4; ++e) { a[e] = logsigm(v[e] + bfg[c + e]); b2[e] = logsigm(v[4 + e] + bfg[c + 4 + e]); }
            *(f32x4*)(logf + (size_t)row * NH + c) = a; *(f32x4*)(logf + (size_t)row * NH + c + 4) = b2; }
        return 0.f; }
};
template <bool SSQ> struct FStore8 { static constexpr bool HAS_SSQ = SSQ, HAS_NORM = false; bf16* base; size_t stride;
    __device__ __forceinline__ float prescale(const pg8::Unit&) const { return 1.f; }
    struct Pre {}; __device__ __forceinline__ Pre load(int, int) const { return Pre{}; }
    __device__ __forceinline__ float operator()(int row, int col, const float* v) const { return apply(row, col, v, Pre{}); }
    __device__ __forceinline__ float apply(int row, int col, const float* v, const Pre&) const {
        __builtin_nontemporal_store(pack8(v), (v4u*)(base + (size_t)(col >> 10) * stride + (size_t)row * DM + (col & (DM - 1))));
        float s = 0.f;
        if (SSQ) {
#pragma unroll
            for (int e = 0; e < 8; ++e) s += v[e] * v[e]; }
        return s; }
};
struct FGlu { static constexpr bool HAS_SSQ = false, HAS_NORM = false; const bf16* g; const bf16* z; const float* bias; bf16* out;
    __device__ __forceinline__ float prescale(const pg8::Unit&) const { return 1.f; }
    struct Pre { v4u g, z; };
    __device__ __forceinline__ Pre load(int row, int col) const { const size_t off = (size_t)row * DM + col; Pre p; p.g = __builtin_nontemporal_load((const v4u*)(g + off)); p.z = __builtin_nontemporal_load((const v4u*)(z + off)); return p; }
    __device__ __forceinline__ float operator()(int row, int col, const float* v) const { return apply(row, col, v, load(row, col)); }
    __device__ __forceinline__ float apply(int row, int col, const float* v, const Pre& p) const {
        const size_t off = (size_t)row * DM + col; float gf[8], zf[8], w[8]; unpack8(p.g, gf); unpack8(p.z, zf);
        const f32x4 b0 = *(const f32x4*)(bias + col), b1 = *(const f32x4*)(bias + col + 4);
#pragma unroll
        for (int e = 0; e < 8; ++e) { const float bb = e < 4 ? b0[e & 3] : b1[e & 3]; w[e] = gf[e] * sigm(v[e] + bb) * zf[e] * sigm(zf[e]); }
        __builtin_nontemporal_store(pack8(w), (v4u*)(out + off)); return 0.f; }
};
template <bool SSQ, bool OUT_F32> struct FGate8 { static constexpr bool HAS_SSQ = SSQ, HAS_NORM = false; const bf16* xi; const bf16* pp; const float* bias; void* xo;
    __device__ __forceinline__ float prescale(const pg8::Unit&) const { return 1.f; }
    struct Pre { v4u x, p; };
    __device__ __forceinline__ Pre load(int row, int col) const { const size_t off = (size_t)row * DM + col; Pre q; q.x = __builtin_nontemporal_load((const v4u*)(xi + off)); q.p = __builtin_nontemporal_load((const v4u*)(pp + off)); return q; }
    __device__ __forceinline__ float operator()(int row, int col, const float* v) const { return apply(row, col, v, load(row, col)); }
    __device__ __forceinline__ float apply(int row, int col, const float* v, const Pre& q) const {
        const size_t off = (size_t)row * DM + col; float xf[8], pf[8], o[8]; unpack8(q.x, xf); unpack8(q.p, pf);
        const f32x4 b0 = *(const f32x4*)(bias + col), b1 = *(const f32x4*)(bias + col + 4);
#pragma unroll
        for (int e = 0; e < 8; ++e) { const float bb = e < 4 ? b0[e & 3] : b1[e & 3]; o[e] = xf[e] + pf[e] * sigm(v[e] + bb); }
        if (OUT_F32) { f32x4 o0, o1;
#pragma unroll
            for (int e = 0; e < 4; ++e) { o0[e] = o[e]; o1[e] = o[4 + e]; }
            __builtin_nontemporal_store(o0, (f32x4*)((float*)xo + off)); __builtin_nontemporal_store(o1, (f32x4*)((float*)xo + off + 4)); }
        else __builtin_nontemporal_store(pack8(o), (v4u*)((bf16*)xo + off));
        float s = 0.f;
        if (SSQ) {
#pragma unroll
            for (int e = 0; e < 8; ++e) s += o[e] * o[e]; }
        return s; }
};

template <int NC, class F> __device__ __forceinline__ void naive_gemm(const bf16* A, const bf16* Bt, int Mr, int N, int K, const F& f, int gtid, int nthr) {
    const long total = (long)Mr * (N / NC);
    for (long idx = gtid; idx < total; idx += nthr) {
        const int cg = (int)(idx / Mr), r = (int)(idx % Mr);
        float acc[NC];
#pragma unroll
        for (int e = 0; e < NC; ++e) acc[e] = 0.f;
        const v4u* ap = (const v4u*)(A + (size_t)r * K);
        for (int k8 = 0; k8 < K / 8; ++k8) { float af[8]; unpack8(ap[k8], af);
#pragma unroll
            for (int e = 0; e < NC; ++e) { float bf_[8]; unpack8(*((const v4u*)(Bt + (size_t)(cg * NC + e) * K) + k8), bf_);
#pragma unroll
                for (int j = 0; j < 8; ++j) acc[e] += af[j] * bf_[j]; } }
        f(r, cg * NC, acc);
    }
}
__device__ __forceinline__ void naive_rowssq_bf16(const bf16* Y, float* ssq, int gw, int ngw, int lane) {
    for (int row = gw; row < M; row += ngw) { float f0[8], f1[8]; unpack8(((const v4u*)(Y + (size_t)row * DM))[lane], f0); unpack8(((const v4u*)(Y + (size_t)row * DM))[64 + lane], f1); float s = 0.f;
#pragma unroll
        for (int e = 0; e < 8; ++e) s += f0[e] * f0[e] + f1[e] * f1[e];
        s = wave_sum(s); if (lane < 16) ssq[(size_t)row * 16 + lane] = lane == 0 ? s : 0.f; }
}
__device__ __forceinline__ void naive_attn(const bf16* Q, const bf16* Kb, const bf16* Vb, const bf16* Z, const float* cum, bf16* O, int gw, int ngw, int lane) {
    for (int rid = gw; rid < M * NH; rid += ngw) {
        const int h = rid & 15, bt = rid >> 4, b = bt >> 11, t = bt & (SEQ - 1);
        const v4u* qp = (const v4u*)(Q + (size_t)bt * DM + h * HD); float q[64];
#pragma unroll
        for (int c = 0; c < 8; ++c) unpack8(qp[c], q + 8 * c);
        const float* cm = cum + (size_t)(b * NH + h) * SEQ; const float cq = cm[t];
        float m = -INFINITY, l = 0.f, o = 0.f;
        for (int s0 = 0; s0 <= t; s0 += 64) {
            const int s = s0 + lane; const v4u* kp = (const v4u*)(Kb + (size_t)(b * SEQ + s) * DM + h * HD); float x = 0.f;
#pragma unroll
            for (int c = 0; c < 8; ++c) { float kf[8]; unpack8(kp[c], kf);
#pragma unroll
                for (int j = 0; j < 8; ++j) x += q[8 * c + j] * kf[j]; }
            x = x + cq - cm[s]; if (s > t) x = -INFINITY;
            const float mn = fmaxf(m, wave_max(x)), alpha = __builtin_amdgcn_exp2f(m - mn), p = __builtin_amdgcn_exp2f(x - mn);
            l = l * alpha + wave_sum(p); o *= alpha;
            const bf16* vp = Vb + (size_t)(b * SEQ + s0) * DM + h * HD + lane;
#pragma unroll 8
            for (int j = 0; j < 64; ++j) o += __shfl(p, j) * bf2f(vp[(size_t)j * DM]);
            m = mn;
        }
        const float z = bf2f(Z[(size_t)bt * DM + h * HD + lane]);
        O[(size_t)bt * DM + h * HD + lane] = (bf16)f2bf(o / l * z * sigm(z));
    }
}
__device__ __forceinline__ void naive_s5(const bf16* U, const float* S5L, const float* S5BB, const float* c_re, const float* c_im, const float* dsk, bf16* G, int gw, int ngw, int lane) {
    for (int unit = gw; unit < BATCH * NG; unit += ngw) {
        const int b = unit / NG, g = unit % NG, s = lane;
        const float are = S5L[(g * NS + s) * 2], aim = S5L[(g * NS + s) * 2 + 1];
        float bre[16], bim[16], cre[16], cim[16];
#pragma unroll
        for (int j = 0; j < 16; ++j) { bre[j] = S5BB[((size_t)(g * NS + s) * 16 + j) * 2]; bim[j] = S5BB[((size_t)(g * NS + s) * 16 + j) * 2 + 1]; cre[j] = c_re[(size_t)(g * GS + j) * NS + s]; cim[j] = c_im[(size_t)(g * GS + j) * NS + s]; }
        const float dd = dsk[g * GS + (lane & 15)];
        float xr = 0.f, xi = 0.f;
        for (int t = 0; t < SEQ; ++t) {
            const bf16* up = U + (size_t)(b * SEQ + t) * DM + g * GS; float uf[16]; unpack8(((const v4u*)up)[0], uf); unpack8(((const v4u*)up)[1], uf + 8);
            float br = 0.f, bi = 0.f;
#pragma unroll
            for (int j = 0; j < 16; ++j) { br += bre[j] * uf[j]; bi += bim[j] * uf[j]; }
            const float nr = are * xr - aim * xi + br, ni = are * xi + aim * xr + bi; xr = nr; xi = ni;
            float myy = 0.f;
#pragma unroll
            for (int i = 0; i < 16; ++i) { const float v = wave_sum(cre[i] * xr - cim[i] * xi); if (lane == i) myy = v; }
            if (lane < 16) G[(size_t)(b * SEQ + t) * DM + g * GS + lane] = (bf16)f2bf(gelu_tanh(myy + dd * bf2f(up[lane])));
        }
    }
}
__device__ __forceinline__ void p0_transpose_item(const float* W, int K, int ldw, int nvalid, int nblk, bf16* WT, LAS float* scr, int item, int lane) {
    const int kb = item / nblk, nb = item % nblk, k0 = 64 * kb, n0 = 32 * nb; const int nn = n0 + (lane & 31); const bool ok = nn < nvalid;
#pragma unroll 8
    for (int i = 0; i < 32; ++i) { const int kk = 2 * i + (lane >> 5); scr[kk * 33 + (lane & 31)] = ok ? W[(size_t)(k0 + kk) * ldw + nn] : 0.f; }
    LDS_WAIT(); asm volatile("" ::: "memory");
    const int c = lane & 7;
#pragma unroll
    for (int j = 0; j < 4; ++j) { const int n = (lane >> 3) + 8 * j; const LAS float* s = scr + (8 * c) * 33 + n;
        v4u o; o.x = pk2(s[0 * 33], s[1 * 33]); o.y = pk2(s[2 * 33], s[3 * 33]); o.z = pk2(s[4 * 33], s[5 * 33]); o.w = pk2(s[6 * 33], s[7 * 33]);
        *(GAS v4u*)(WT + (size_t)(n0 + n) * K + k0 + 8 * c) = o; }
    LDS_WAIT(); asm volatile("" ::: "memory");
}
__device__ __forceinline__ void rms_row_bf16(const float* xrow, const float* gain, bf16* orow, float tot, int lane) {
    const f32x4* xr = (const f32x4*)xrow; const f32x4* gr = (const f32x4*)gain;
    f32x4 v[4] = {xr[2 * lane], xr[2 * lane + 1], xr[128 + 2 * lane], xr[128 + 2 * lane + 1]};
    if (tot < 0.f) { float s = 0.f;
#pragma unroll
        for (int j = 0; j < 4; ++j) s += (v[j][0] * v[j][0] + v[j][1] * v[j][1]) + (v[j][2] * v[j][2] + v[j][3] * v[j][3]);
        tot = wave_sum(s); }
    const float rstd = 1.0f / sqrtf(tot * (1.0f / DM) + RMS_EPS);
    const f32x4 g[4] = {gr[2 * lane], gr[2 * lane + 1], gr[128 + 2 * lane], gr[128 + 2 * lane + 1]};
    float w[16];
#pragma unroll
    for (int j = 0; j < 4; ++j)
#pragma unroll
        for (int e = 0; e < 4; ++e) w[4 * j + e] = v[j][e] * rstd * g[j][e];
    ((v4u*)orow)[lane] = pack8(w); ((v4u*)orow)[64 + lane] = pack8(w + 8);
}
__device__ __forceinline__ void rms_row_bf16_b(const bf16* xrow, const float* gain, bf16* orow, float tot, int lane) {
    const f32x4* gr = (const f32x4*)gain; float v[16]; unpack8(((const v4u*)xrow)[lane], v); unpack8(((const v4u*)xrow)[64 + lane], v + 8);
    const float rstd = 1.0f / sqrtf(tot * (1.0f / DM) + RMS_EPS);
    const f32x4 g[4] = {gr[2 * lane], gr[2 * lane + 1], gr[128 + 2 * lane], gr[128 + 2 * lane + 1]};
    float w[16];
#pragma unroll
    for (int j = 0; j < 4; ++j)
#pragma unroll
        for (int e = 0; e < 4; ++e) w[4 * j + e] = v[4 * j + e] * rstd * g[j][e];
    ((v4u*)orow)[lane] = pack8(w); ((v4u*)orow)[64 + lane] = pack8(w + 8);
}
__device__ __forceinline__ float row_ssq_total(const float* ssq, int row, int lane) {
    float s = ssq[(size_t)row * 16 + (lane & 15)];
    s += __shfl_xor(s, 1); s += __shfl_xor(s, 2); s += __shfl_xor(s, 4); s += __shfl_xor(s, 8); return s;
}
template <bool XF32> __device__ __forceinline__ void resid_phase(const void* xi, const bf16* y, const float* ssq, const float* gain, bf16* xb, int row_lo, int row_hi, int rstep, int lane) {
    for (int row = row_lo; row < row_hi; row += rstep) {
        const float rstd = 1.0f / sqrtf(row_ssq_total(ssq, row, lane) * (1.0f / DM) + RMS_EPS);
        const f32x4* gr = (const f32x4*)gain;
        float yv[16], xv[16]; unpack8(((const v4u*)(y + (size_t)row * DM))[lane], yv); unpack8(((const v4u*)(y + (size_t)row * DM))[64 + lane], yv + 8);
        if (XF32) { const f32x4* xr = (const f32x4*)((const float*)xi + (size_t)row * DM);
#pragma unroll
            for (int j = 0; j < 4; ++j) { const f32x4 t = xr[(j >> 1) * 128 + 2 * lane + (j & 1)];
#pragma unroll
                for (int e = 0; e < 4; ++e) xv[4 * j + e] = t[e]; } }
        else { unpack8(((const v4u*)((const bf16*)xi + (size_t)row * DM))[lane], xv); unpack8(((const v4u*)((const bf16*)xi + (size_t)row * DM))[64 + lane], xv + 8); }
        float w[16];
#pragma unroll
        for (int j = 0; j < 4; ++j) { const f32x4 gv = gr[(j >> 1) * 128 + 2 * lane + (j & 1)];
#pragma unroll
            for (int e = 0; e < 4; ++e) w[4 * j + e] = xv[4 * j + e] + yv[4 * j + e] * rstd * gv[e]; }
        ((v4u*)(xb + (size_t)row * DM))[lane] = pack8(w); ((v4u*)(xb + (size_t)row * DM))[64 + lane] = pack8(w + 8);
    }
}
__device__ __forceinline__ void s5_coef(const float* lam_re, const float* lam_im, const float* log_dt, int g, int s, float& lbr, float& lbi, float& cr, float& ci) {
    const float lr = lam_re[g * NS + s], li = lam_im[g * NS + s], dt = expf(log_dt[g]);
    const float zr = lr * dt, th = li * dt, mag = expf(zr), sn = sinf(th), cs = cosf(th), sh = sinf(0.5f * th);
    lbr = mag * cs; lbi = mag * sn;
    const float nr = expm1f(zr) * cs - 2.f * sh * sh, ni = lbi, den = lr * lr + li * li;
    cr = (nr * lr + ni * li) / den; ci = (ni * lr - nr * li) / den;
}
__device__ __forceinline__ float fma_s(float a, float b, float c) { float r; asm("v_fma_f32 %0, %1, %2, %3" : "=v"(r) : "v"(a), "v"(b), "v"(c)); return r; }
__device__ __forceinline__ float mul_s(float a, float b) { float r; asm("v_mul_f32_e32 %0, %1, %2" : "=v"(r) : "v"(a), "v"(b)); return r; }
__device__ __forceinline__ float gelu_s(float v) {
    const float v2 = mul_s(v, v), w = fma_s(v2, 0.044715f * -1.5957691216057308f * LOG2E, -1.5957691216057308f * LOG2E), e = __builtin_amdgcn_exp2f(mul_s(w, v));
    return v * __builtin_amdgcn_rcpf(1.f + e); }
constexpr int S5_ROWB = 272, S5_WAVE_LDS = 32 * S5_ROWB + 1024, S5_PF = 4;
static_assert(NWAVES * S5_WAVE_LDS <= RING_BYTES, "S5 LDS");
__device__ __forceinline__ void s5_phase(const bf16* __restrict__ U, const bf16* __restrict__ S5B, const bf16* __restrict__ S5C, const float* __restrict__ S5L, const float* __restrict__ dsk, bf16* __restrict__ Gout,
                                         LAS unsigned char* lds, int vcu, int G, int wave, int lane) {
    typedef float f32x16 __attribute__((ext_vector_type(16)));
    LAS unsigned char* const xs = lds + wave * S5_WAVE_LDS;
    const int n = lane & 31, h = lane >> 5, t16 = lane & 15, rq = lane >> 4;
    for (int unit = vcu; unit < BATCH * (NG / 8); unit += G) {
        const int b = unit >> 3, g = (unit & 7) * 8 + wave;
        bf16x8 bfr[4], cfr[4];
#pragma unroll
        for (int q = 0; q < 4; ++q) { bfr[q] = ((const bf16x8*)S5B)[(g * 4 + q) * 64 + lane]; cfr[q] = ((const bf16x8*)S5C)[(g * 4 + q) * 64 + lane]; }
        const int st = 2 * n + h; const float are = S5L[(g * NS + st) * 2], aim = S5L[(g * NS + st) * 2 + 1], naim = -aim;
        const f32x4 dv = *(const f32x4*)(dsk + g * GS + 4 * rq);
        float xr = 0.f, xi = 0.f;
        const bf16* ub = U + (size_t)b * SEQ * DM + g * GS; bf16* gb = Gout + (size_t)b * SEQ * DM + g * GS;
        LAS unsigned char* const us = xs + 32 * S5_ROWB;
        bf16x8 ring[S5_PF];
#pragma unroll
        for (int p = 0; p < S5_PF; ++p) ring[p] = *(const bf16x8*)(ub + (size_t)(p * 32 + n) * DM + 8 * h);
        for (int blk0 = 0; blk0 < SEQ / 32; blk0 += S5_PF) {
#pragma unroll
            for (int p = 0; p < S5_PF; ++p) {
                const int blk = blk0 + p;
                const bf16x8 acur = ring[p];
                if (blk + S5_PF < SEQ / 32) ring[p] = *(const bf16x8*)(ub + (size_t)((blk + S5_PF) * 32 + n) * DM + 8 * h);
                *(LAS bf16x8*)(us + n * 32 + 16 * h) = acur;
                f32x16 T0 = {}, T1 = {}, T2 = {}, T3 = {};
                T0 = __builtin_amdgcn_mfma_f32_32x32x16_bf16(acur, bfr[0], T0, 0, 0, 0); T1 = __builtin_amdgcn_mfma_f32_32x32x16_bf16(acur, bfr[1], T1, 0, 0, 0);
                T2 = __builtin_amdgcn_mfma_f32_32x32x16_bf16(acur, bfr[2], T2, 0, 0, 0); T3 = __builtin_amdgcn_mfma_f32_32x32x16_bf16(acur, bfr[3], T3, 0, 0, 0);
#pragma unroll
                for (int r = 0; r < 16; ++r) {
                    auto a = __builtin_amdgcn_permlane32_swap(__float_as_uint(T0[r]), __float_as_uint(T2[r]), false, false); T0[r] = __uint_as_float(a[0]); T2[r] = __uint_as_float(a[1]);
                    auto c = __builtin_amdgcn_permlane32_swap(__float_as_uint(T1[r]), __float_as_uint(T3[r]), false, false); T1[r] = __uint_as_float(c[0]); T3[r] = __uint_as_float(c[1]);
                }
                LAS unsigned* const xw = (LAS unsigned*)(xs + (4 * n + 2 * h) * 2);
#pragma unroll
                for (int R = 0; R < 4; ++R) {
#pragma unroll
                    for (int i = 0; i < 4; ++i) { const int r = 4 * R + i, t = 8 * R + i; const float nr = fma_s(are, xr, fma_s(naim, xi, T0[r])), ni = fma_s(are, xi, fma_s(aim, xr, T1[r])); xr = nr; xi = ni; xw[t * (S5_ROWB / 4)] = attn_body::cvtpk_s(xr, xi); }
#pragma unroll
                    for (int i = 0; i < 4; ++i) { const int r = 4 * R + i, t = 8 * R + 4 + i; const float nr = fma_s(are, xr, fma_s(naim, xi, T2[r])), ni = fma_s(are, xi, fma_s(aim, xr, T3[r])); xr = nr; xi = ni; xw[t * (S5_ROWB / 4)] = attn_body::cvtpk_s(xr, xi); }
                }
#pragma unroll
                for (int ct = 0; ct < 2; ++ct) {
                    f32x4 y = {0.f, 0.f, 0.f, 0.f};
#pragma unroll
                    for (int ks = 0; ks < 4; ++ks) { const bf16x8 xb = *(const LAS bf16x8*)(xs + (16 * ct + t16) * S5_ROWB + 64 * ks + 16 * rq); y = __builtin_amdgcn_mfma_f32_16x16x32_bf16(cfr[ks], xb, y, 0, 0, 0); }
                    const unsigned long long uu = *(const LAS unsigned long long*)(us + (16 * ct + t16) * 32 + 8 * rq);
                    const float u0 = lo_f((unsigned)uu), u1 = hi_f((unsigned)uu), u2 = lo_f((unsigned)(uu >> 32)), u3 = hi_f((unsigned)(uu >> 32));
                    const float q0 = y[0] + dv[0] * u0, q1 = y[1] + dv[1] * u1, q2 = y[2] + dv[2] * u2, q3 = y[3] + dv[3] * u3;
                    const float g0 = gelu_s(q0), g1 = gelu_s(q1), g2 = gelu_s(q2), g3 = gelu_s(q3);
                    *(unsigned long long*)(gb + (size_t)(blk * 32 + 16 * ct + t16) * DM + 4 * rq) = (unsigned long long)attn_body::cvtpk_s(g0, g1) | ((unsigned long long)attn_body::cvtpk_s(g2, g3) << 32);
                }
            }
        }
    }
}
struct Args { const float* in[22]; float* out; unsigned char* ws; int ph_lo, ph_hi; };
static_assert(sizeof(Args) == 24 * 8 + 8, "Args has no padding");
constexpr int N_PHASES = 12;
__device__ __forceinline__ void batch_barrier(gu32* cnt, unsigned target, gu32* tmo) {
    asm volatile("s_waitcnt vmcnt(0)" ::: "memory"); __syncthreads();
    if (threadIdx.x == 0) {
        __builtin_amdgcn_fence(__ATOMIC_RELEASE, "agent"); asm volatile("s_waitcnt vmcnt(0)" ::: "memory");
        __hip_atomic_fetch_add(cnt, 1u, RLX_AGENT);
        unsigned sp = 0; while (__hip_atomic_load(cnt, RLX_AGENT) < target) { __builtin_amdgcn_s_sleep(1); if (++sp > (1u << 24)) { __hip_atomic_store(tmo, 1u, RLX_AGENT); break; } }
        __builtin_amdgcn_fence(__ATOMIC_ACQUIRE, "agent"); asm volatile("s_waitcnt vmcnt(0)" ::: "memory");
    }
    __syncthreads();
}
struct PanelOrder { int pm, nN;
    __device__ __forceinline__ bool next(int i, pg8::Unit& u) const { if (i >= nN) return false; u.pm = pm; u.pn = i; return true; }
    __device__ __forceinline__ void a_ready(const pg8::Unit&) const {}
    __device__ __forceinline__ void done(const pg8::Unit&) const {} };
__global__ void __launch_bounds__(NWAVES * 64, 2) fwd_kernel(Args args) {
    extern __shared__ __attribute__((aligned(16))) unsigned char lds[];
    LAS unsigned char* const L = (LAS unsigned char*)lds;
    volatile LAS unsigned* const MISC = (volatile LAS unsigned*)(L + MISC_OFF);
    const int tid = threadIdx.x, lane = tid & 63, wave = __builtin_amdgcn_readfirstlane(tid >> 6);
    const int G = gridDim.x, bx = blockIdx.x;
    const int gw = bx * NWAVES + wave, ngw = G * NWAVES, gtid = bx * (NWAVES * 64) + tid, nthr = G * NWAVES * 64;
    unsigned char* const ws = args.ws;
    gu32* const ctl = (gu32*)(ws + WS_CTL);
    const float* const x = args.in[0]; const float* const pin = args.in[1]; const float* const ln_pre = args.in[2]; const float* const ln_post = args.in[3];
    const float* const fox_w_in = args.in[4]; const float* const fox_b_f = args.in[5]; const float* const fox_w_out = args.in[6]; const float* const s5_w_in = args.in[7];
    const float* const lam_re = args.in[8]; const float* const lam_im = args.in[9]; const float* const log_dt = args.in[10]; const float* const b_re = args.in[11]; const float* const b_im = args.in[12];
    const float* const c_re = args.in[13]; const float* const c_im = args.in[14]; const float* const s5_d = args.in[15]; const float* const w_glu = args.in[16]; const float* const b_glu = args.in[17];
    const float* const s5_w_out = args.in[18]; const float* const ple_w_proj = args.in[19]; const float* const ple_w_gate = args.in[20]; const float* const ple_b_gate = args.in[21];
    float* const out = args.out;
    bf16* const Win0 = (bf16*)(ws + WS_WIN0); bf16* const Wout0 = (bf16*)(ws + WS_WOUT0); bf16* const Wg0 = (bf16*)(ws + WS_WG0); bf16* const Wp0 = (bf16*)(ws + WS_WP0);
    bf16* const Win1 = (bf16*)(ws + WS_WIN1); bf16* const Wglu = (bf16*)(ws + WS_WGLU); bf16* const Wout1 = (bf16*)(ws + WS_WOUT1); bf16* const Wg1 = (bf16*)(ws + WS_WG1); bf16* const Wp1 = (bf16*)(ws + WS_WP1);
    float* const S5L = (float*)(ws + WS_S5L); float* const S5BB = (float*)(ws + WS_S5BB); bf16* const S5B = (bf16*)(ws + WS_S5B); bf16* const S5C = (bf16*)(ws + WS_S5C);
    bf16* const HN = (bf16*)(ws + WS_HN); bf16* const QB_ = (bf16*)(ws + WS_Q); bf16* const KB = (bf16*)(ws + WS_K); bf16* const VB = (bf16*)(ws + WS_V); bf16* const ZB = (bf16*)(ws + WS_Z);
    bf16* const PB = (bf16*)(ws + WS_PB); float* const LOGF = (float*)(ws + WS_LOGF); float* const SSQ = (float*)(ws + WS_SSQ); bf16* const X2 = (bf16*)(ws + WS_X2); float* const CUM = (float*)(ws + WS_CUM);
    constexpr size_t TSTRIDE = (WS_K - WS_Q) / 2;
    for (int u = tid; u < (LDS_BYTES - LDSCTL_OFF) / 4; u += NWAVES * 64) ((LAS unsigned*)(L + LDSCTL_OFF))[u] = 0u;
    __syncthreads();
    XcdBarrier bar = xcd_barrier_post((unsigned*)(ctl + CW_BAR), MISC + 8);
    const int lo = args.ph_lo, hi = args.ph_hi;
    const int vcu_ = (G % 8 == 0) ? (bx % 8) * (G / 8) + bx / 8 : bx;
    gu32* const bcnt = ctl + CW_GRP + (vcu_ >> 3) * 64; unsigned btarget = 0u;
#define IN(k) (lo <= (k) && (k) < hi)
#define SEAM(k) do { if (IN(k) && (k) + 1 < hi) xcd_barrier(bar); } while (0)
#define FAST(k) (((PH_FAST) >> (k)) & 1)
#define BATCH_GROUPS (FAST(3) && FAST(10) && G == 256)
#define BSEAM(k) do { if (IN(k) && (k) + 1 < hi) { if (BATCH_GROUPS) { btarget += 8u; batch_barrier(bcnt, btarget, ctl + CW_TMO); } else xcd_barrier(bar); } } while (0)
#define REPS(k) ((k) == (PROBE_PHASE) ? (PROBE_REPS) : 1)
#define PH_BEGIN(k) if (IN(k)) { for (int rep_ = 0; rep_ < REPS(k); ++rep_) { if (rep_) xcd_barrier(bar);
#define PH_END(k) } SEAM(k); }
#define WG_SYNC() do { asm volatile("s_waitcnt vmcnt(0)" ::: "memory"); __syncthreads(); } while (0)
#define PANEL_GEMM(EPI, FUNC, Aop, Bop, NN, KK, SSQP) do { int kk_ = (KK); asm volatile("" : "+s"(kk_));   pg8::Gemm g_{(const pg8::bf16_t*)(Aop), (const pg8::bf16_t*)(Bop), M, (NN), kk_}; const PanelOrder S_{pm, (NN) / 256}; \
        const EPI<decltype(FUNC)> E_{(FUNC), (SSQP)}; pg8::gemm_phase<EPI<decltype(FUNC)>, PanelOrder, true, true>(L + RING_OFF, g_, S_, E_); } while (0)
#define RUN_GEMM(k, NCV, EPI, FUNC, Aop, Bop, NN, KK, SSQP) do { \
        if (FAST(k)) { pg8::Gemm g_{(const pg8::bf16_t*)(Aop), (const pg8::bf16_t*)(Bop), M, (NN), (KK)}; pg8::StaticOrder S_; S_.init(M, (NN), G, bx); \
            const EPI<decltype(FUNC)> E_{(FUNC), (SSQP)}; pg8::gemm_phase<EPI<decltype(FUNC)>, pg8::StaticOrder, true, true>(L + RING_OFF, g_, S_, E_); } \
        else naive_gemm<NCV>((Aop), (Bop), M, (NN), (KK), (FUNC), gtid, nthr); } while (0)

    PH_BEGIN(0)
        LAS float* scr = (LAS float*)(L + RING_OFF + wave * 16384);
        constexpr int I_IN0 = (DM / 64) * (NIN0P / 32), I_SQ = (DM / 64) * (DM / 32), I_IN1 = (DM / 64) * (2 * DM / 32), I_P = (PLE / 64) * (DM / 32);
        constexpr int NITEMS = I_IN0 + 5 * I_SQ + I_IN1 + 2 * I_P;
        for (int it = gw; it < NITEMS; it += ngw) {
            int r = it;
            if (r < I_IN0) { p0_transpose_item(fox_w_in, DM, NIN0, NIN0, NIN0P / 32, Win0, scr, r, lane); continue; } r -= I_IN0;
            if (r < I_SQ) { p0_transpose_item(fox_w_out, DM, DM, DM, DM / 32, Wout0, scr, r, lane); continue; } r -= I_SQ;
            if (r < I_SQ) { p0_transpose_item(ple_w_gate, DM, DM, DM, DM / 32, Wg0, scr, r, lane); continue; } r -= I_SQ;
            if (r < I_SQ) { p0_transpose_item(ple_w_gate + (size_t)DM * DM, DM, DM, DM, DM / 32, Wg1, scr, r, lane); continue; } r -= I_SQ;
            if (r < I_SQ) { p0_transpose_item(w_glu, DM, DM, DM, DM / 32, Wglu, scr, r, lane); continue; } r -= I_SQ;
            if (r < I_SQ) { p0_transpose_item(s5_w_out, DM, DM, DM, DM / 32, Wout1, scr, r, lane); continue; } r -= I_SQ;
            if (r < I_IN1) { p0_transpose_item(s5_w_in, DM, 2 * DM, 2 * DM, 2 * DM / 32, Win1, scr, r, lane); continue; } r -= I_IN1;
            if (r < I_P) { p0_transpose_item(ple_w_proj, PLE, DM, DM, DM / 32, Wp0, scr, r, lane); continue; } r -= I_P;
            p0_transpose_item(ple_w_proj + (size_t)PLE * DM, PLE, DM, DM, DM / 32, Wp1, scr, r, lane);
        }
        for (int m = gw; m < M; m += ngw) rms_row_bf16(x + (size_t)m * DM, ln_pre, HN + (size_t)m * DM, -1.f, lane);
        for (long i = gtid; i < (long)2 * M * PLE / 8; i += nthr) { const f32x4 a = ((const f32x4*)pin)[2 * i], b2 = ((const f32x4*)pin)[2 * i + 1]; v4u o; o.x = pk2(a[0], a[1]); o.y = pk2(a[2], a[3]); o.z = pk2(b2[0], b2[1]); o.w = pk2(b2[2], b2[3]); ((v4u*)PB)[i] = o; }
        for (int i = gtid; i < NG * NS; i += nthr) { const int g = i / NS, s = i % NS; float lbr, lbi, cr, ci; s5_coef(lam_re, lam_im, log_dt, g, s, lbr, lbi, cr, ci);
            S5L[2 * i] = lbr; S5L[2 * i + 1] = lbi;
            for (int j = 0; j < GS; ++j) { const float br = b_re[(size_t)i * GS + j], bi = b_im[(size_t)i * GS + j]; S5BB[((size_t)i * GS + j) * 2] = cr * br - ci * bi; S5BB[((size_t)i * GS + j) * 2 + 1] = cr * bi + ci * br; } }
        for (int i = gtid; i < NG * 4 * 64; i += nthr) {
            const int g = i >> 8, q = (i >> 6) & 3, ln = i & 63, n = ln & 31, h = ln >> 5, s = 2 * n + (q >> 1); float lbr, lbi, cr, ci; s5_coef(lam_re, lam_im, log_dt, g, s, lbr, lbi, cr, ci); float w[8];
            _Pragma("unroll") for (int jj = 0; jj < 8; ++jj) { const int j = 8 * h + jj; const float br = b_re[(size_t)(g * NS + s) * GS + j], bi = b_im[(size_t)(g * NS + s) * GS + j]; w[jj] = (q & 1) ? (cr * bi + ci * br) : (cr * br - ci * bi); }
            ((v4u*)S5B)[i] = pack8(w); }
        for (int i = gtid; i < NG * 4 * 64; i += nthr) {
            const int g = i >> 8, ks = (i >> 6) & 3, ln = i & 63, ch = ln & 15, kq = ln >> 4; float w[8];
            _Pragma("unroll") for (int jj = 0; jj < 8; ++jj) { const int comp = 32 * ks + 8 * kq + jj, s = comp >> 1; w[jj] = (comp & 1) ? -c_im[(size_t)(g * GS + ch) * NS + s] : c_re[(size_t)(g * GS + ch) * NS + s]; }
            ((v4u*)S5C)[i] = pack8(w); }
    PH_END(0)
#ifdef STAGGER_TICKS
    { const unsigned long long t0_ = __builtin_amdgcn_s_memrealtime(), w_ = (unsigned long long)(bx & 7) * STAGGER_TICKS; while (__builtin_amdgcn_s_memrealtime() - t0_ < w_) __builtin_amdgcn_s_sleep(4); }
#endif
    PH_BEGIN(1) FInProj0 f{QB_, TSTRIDE, fox_b_f, LOGF, (unsigned*)(ctl + CW_QN), (unsigned*)(ctl + CW_KN)}; RUN_GEMM(1, 8, pg8::Epi8, f, HN, Win0, NIN0P, DM, nullptr); PH_END(1)
    if (!FAST(3)) {
    PH_BEGIN(2)
        for (int sq = gw; sq < BATCH * NH; sq += ngw) { const int b = sq >> 4, h = sq & 15; float v[32]; float run = 0.f;
#pragma unroll
            for (int i = 0; i < 32; ++i) { run += LOGF[(size_t)(b * SEQ + lane * 32 + i) * NH + h]; v[i] = run; }
            float incl = run;
#pragma unroll
            for (int o = 1; o < 64; o <<= 1) { const float t = __shfl_up(incl, o); if (lane >= o) incl += t; }
            const float base = incl - run;
#pragma unroll
            for (int i = 0; i < 32; i += 4) { f32x4 w; w[0] = (base + v[i]) * LOG2E; w[1] = (base + v[i + 1]) * LOG2E; w[2] = (base + v[i + 2]) * LOG2E; w[3] = (base + v[i + 3]) * LOG2E; *(f32x4*)(CUM + (size_t)sq * SEQ + lane * 32 + i) = w; } }
    PH_END(2)
    }
    PH_BEGIN(3)
        if (FAST(3)) { static_assert(attn_body::ATTN_LDS_BYTES <= RING_BYTES && attn_body::ATTN_PITCH == DM, "attention body geometry vs frame");
            const attn_body::AttnTensors AT{(const attn_body::bf16*)QB_, (const attn_body::bf16*)KB, (const attn_body::bf16*)VB, (attn_body::bf16*)HN, (const attn_body::bf16*)ZB, LOGF, FAST(1) ? (const float*)(ctl + CW_QN) : nullptr, (const float*)(ctl + CW_KN)};
            LAS int* const hperm = (LAS int*)(L + RING_OFF + attn_body::LDS_AB + 64);
            if (tid < NH) { const float my = fox_b_f[tid]; int r = 0;
#pragma unroll
                for (int j = 0; j < NH; ++j) { const float o = fox_b_f[j]; r += (o < my || (o == my && j < tid)) ? 1 : 0; }
                hperm[r] = tid; }
            __syncthreads();
            const attn_body::StaticOrder S(G, bx, (const int*)hperm);
            attn_body::attn_phase<attn_body::StaticOrder, ATT_THRL>((char*)lds + RING_OFF, AT, S);
        }
        else naive_attn(QB_, KB, VB, ZB, CUM, HN, gw, ngw, lane);
#ifdef PROBE_SPIN3_WORD
        if (tid == 0) { const unsigned long long ticks_ = (unsigned long long)MISC[PROBE_SPIN3_WORD] * PROBE_SPIN_SCALE, t0_ = __builtin_amdgcn_s_memrealtime(); while (__builtin_amdgcn_s_memrealtime() - t0_ < ticks_) __builtin_amdgcn_s_sleep(10); }
#endif
    } BSEAM(3); }
    PH_BEGIN(4)
        if (vcu_ < M / 256) { const int pm = vcu_;
            const int r_lo = pm * 256 + wave, r_hi = pm * 256 + 256;
            { FStore8<true> f{VB, 0}; PANEL_GEMM(pg8::Epi8, f, HN, Wout0, DM, DM, SSQ); }
            WG_SYNC();
            resid_phase<true>(x, VB, SSQ, ln_post, HN, r_lo, r_hi, NWAVES, lane);
            { FStore8<false> f{KB, 0}; PANEL_GEMM(pg8::Epi8, f, PB, Wp0, DM, PLE, nullptr); }
            WG_SYNC();
            { FGate8<true, false> f{HN, KB, ple_b_gate, X2}; PANEL_GEMM(pg8::Epi8, f, HN, Wg0, DM, DM, SSQ); }
            WG_SYNC();
            for (int m = r_lo; m < r_hi; m += NWAVES) rms_row_bf16_b(X2 + (size_t)m * DM, ln_pre + DM, HN + (size_t)m * DM, row_ssq_total(SSQ, m, lane), lane);
            WG_SYNC();
            { FStore8<false> f{QB_, TSTRIDE}; PANEL_GEMM(pg8::Epi8, f, HN, Win1, 2 * DM, DM, nullptr); }
            WG_SYNC();
        }
    } BSEAM(4); }
    PH_BEGIN(10) if (FAST(10)) { const int vcu = (G % 8 == 0) ? (bx % 8) * (G / 8) + bx / 8 : bx; s5_phase(QB_, S5B, S5C, S5L, s5_d, VB, L + RING_OFF, vcu, G, wave, lane); }
                  else naive_s5(QB_, S5L, S5BB, c_re, c_im, s5_d, VB, gw, ngw, lane);
    } BSEAM(10); }
    if (IN(11)) {
        if (vcu_ < M / 256) { const int pm = vcu_;
            const int r_lo = pm * 256 + wave, r_hi = pm * 256 + 256;
            { FGlu f{VB, KB, b_glu, ZB}; PANEL_GEMM(pg8::Epi8, f, VB, Wglu, DM, DM, nullptr); }
            WG_SYNC();
            { FStore8<true> f{QB_, 0}; PANEL_GEMM(pg8::Epi8, f, ZB, Wout1, DM, DM, SSQ); }
            WG_SYNC();
            resid_phase<false>(X2, QB_, SSQ, ln_post + DM, HN, r_lo, r_hi, NWAVES, lane);
            { FStore8<false> f{KB, 0}; PANEL_GEMM(pg8::Epi8, f, PB + (size_t)M * PLE, Wp1, DM, PLE, nullptr); }
            WG_SYNC();
            { FGate8<false, true> f{HN, KB, ple_b_gate + DM, out}; PANEL_GEMM(pg8::Epi8, f, HN, Wg1, DM, DM, nullptr); }
            WG_SYNC();
        }
    }
#ifdef PROBE_SPINEND_WORD
    if (tid == 0) { const unsigned long long ticks_ = (unsigned long long)MISC[PROBE_SPINEND_WORD], t0_ = __builtin_amdgcn_s_memrealtime(); while (__builtin_amdgcn_s_memrealtime() - t0_ < ticks_) __builtin_amdgcn_s_sleep(10); }
#endif
#undef IN
#undef SEAM
#undef BSEAM
#undef BATCH_GROUPS
#undef FAST
#undef RUN_GEMM
#undef PANEL_GEMM
#undef WG_SYNC
#undef REPS
#undef PH_BEGIN
#undef PH_END
}

extern "C" void kernel_launch(void* const* d_in, const int* in_sizes, int n_in, void* d_out, int out_size, void* d_ws, size_t ws_size, hipStream_t stream) {
    static int grid = 0;
    if (grid == 0) {
        if (n_in != 22 || in_sizes[0] != M * DM || out_size != M * DM || ws_size < WS_END) { fprintf(stderr, "kernel_launch: built for 22 inputs, x/out of %d floats, >= %zu bytes of workspace; got n_in %d, in0 %d, out %d, ws %zu; nothing launched\n", M * DM, (size_t)WS_END, n_in, n_in > 0 ? in_sizes[0] : -1, out_size, ws_size); grid = -1; return; }
        int dev = 0, cus = 0, per_cu = 0;
        if (hipGetDevice(&dev) != hipSuccess || hipDeviceGetAttribute(&cus, hipDeviceAttributeMultiprocessorCount, dev) != hipSuccess) { fprintf(stderr, "kernel_launch: hipGetDevice / hipDeviceGetAttribute failed\n"); grid = -1; return; }
        if (hipFuncSetAttribute((const void*)fwd_kernel, hipFuncAttributeMaxDynamicSharedMemorySize, LDS_BYTES) != hipSuccess) { fprintf(stderr, "kernel_launch: hipFuncSetAttribute failed\n"); grid = -1; return; }
        if (hipOccupancyMaxActiveBlocksPerMultiprocessor(&per_cu, (const void*)fwd_kernel, NWAVES * 64, LDS_BYTES) != hipSuccess || per_cu < 1) { fprintf(stderr, "kernel_launch: occupancy query reports %d workgroups per CU; nothing launched\n", per_cu); (void)hipGetLastError(); grid = -1; return; }
        if (cus < M / 256) { fprintf(stderr, "kernel_launch: this build needs >= %d CUs (one 256-row panel per workgroup in the chain phases); device has %d; nothing launched\n", M / 256, cus); grid = -1; return; }
        grid = cus;
    }
    if (grid < 0) return;
    if (hipMemsetAsync((char*)d_ws + WS_CTL, 0, CTL_ZERO_BYTES, stream) != hipSuccess) { fprintf(stderr, "kernel_launch: hipMemsetAsync failed\n"); return; }
    Args a{};
    for (int i = 0; i < 22; ++i) a.in[i] = (const float*)d_in[i];
    a.out = (float*)d_out; a.ws = (unsigned char*)d_ws; a.ph_lo = 0; a.ph_hi = N_PHASES;
    hipLaunchKernelGGL(fwd_kernel, dim3(grid), dim3(NWAVES * 64), LDS_BYTES, stream, a);
    const hipError_t le = hipPeekAtLastError();
    if (le != hipSuccess) fprintf(stderr, "kernel_launch: launch failed: %s\n", hipGetErrorName(le));
}
```

```cpp
#include <hip/hip_runtime.h>
#include <hip/hip_bf16.h>
#include <cstdio>
#include <cstdint>
#include <cmath>
namespace pg8 {
#define PG8_LAS __attribute__((address_space(3)))
typedef unsigned short bf16_t;
typedef short bf16x8 __attribute__((ext_vector_type(8)));
typedef float f32x4 __attribute__((ext_vector_type(4)));
typedef unsigned u32x4 __attribute__((ext_vector_type(4)));
constexpr int BM = 256, BK = 64, HALF = 128, HTB = HALF * BK * 2  , STAGE_BYTES = 8 * HTB, NXCD = 8, WGM = 8;

__host__ __device__ __forceinline__ int lds_byte(int r, int c) { const int st = (r >> 4) * 2 + (c >> 5), rr = r & 15, cc = c & 31, ob = rr * 64 + cc * 2; return st * 1024 + (ob ^ (((ob >> 9) & 1) << 5)); }
__host__ __device__ __forceinline__ void stage_rc(int b, int& R, int& C) { const int st = b / 1024, sb = b % 1024, swz = sb ^ (((sb >> 9) & 1) << 5); R = (st >> 1) * 16 + swz / 64; C = (st & 1) * 32 + (swz % 64) / 2; }
__host__ __device__ __forceinline__ int perm32(int rho) { const int n = rho >> 4, i = rho & 15; return 8 * (i >> 2) + 4 * n + (i & 3); }

struct Unit { int pm, pn; };
struct Gemm { const bf16_t* A; const bf16_t* Bt; int M, N, K; int a_tiled = 0; };

struct StaticOrder { static constexpr int IS_STATIC = 1;
    int nM, nN, nwg, G, c;
    __host__ __device__ void init(int M, int N, int G_, int c_) { nM = M / BM; nN = N / BM; nwg = nM * nN; G = G_; c = c_; }
    __host__ __device__ bool next(int i, Unit& u) const {
        const long L = (long)i * G + c; if (L >= nwg) return false;
        int wgid = (int)L; { const int q = nwg / NXCD, r = nwg % NXCD, xcd = wgid % NXCD, off = wgid / NXCD; wgid = (xcd < r ? xcd * (q + 1) : r * (q + 1) + (xcd - r) * q) + off; }
        const int nig = WGM * nN, gid = wgid / nig, fm = gid * WGM, gsz = (nM - fm) < WGM ? (nM - fm) : WGM;
        u.pm = fm + ((wgid % nig) % gsz); u.pn = (wgid % nig) / gsz; return true;
    }
    __device__ __forceinline__ void a_ready(const Unit&) const {}
    __device__ __forceinline__ void done(const Unit&) const {}
};

__device__ __forceinline__ unsigned cvt_pk_bf16(float lo, float hi) { unsigned r; asm volatile("v_cvt_pk_bf16_f32 %0, %1, %2" : "=v"(r) : "v"(lo), "v"(hi)); return r; }
typedef float f32x2 __attribute__((ext_vector_type(2)));
template <int CTRL> __device__ __forceinline__ float dpp_mov(float v) { return __builtin_bit_cast(float, __builtin_amdgcn_update_dpp(0, __builtin_bit_cast(int, v), CTRL, 0xf, 0xf, false)); }
__device__ __forceinline__ float quad_sum(float t) { t += dpp_mov<0xB1>(t); t += dpp_mov<0x4E>(t); return t; }
__device__ __forceinline__ float row16_sum(float t) { t = quad_sum(t); t += dpp_mov<0x124>(t); t += dpp_mov<0x128>(t); return t; }
constexpr int EPI_STG_OFF = 131072 + 1024, EPI_STG_BYTES = 2 * 8192, EPI_RS_OFF = EPI_STG_OFF + EPI_STG_BYTES;
template <class F> struct Epi8 {
    using Fn = F;
    static constexpr bool PERM = true, AFTER_DRAIN = false; F f; float* ssq;
    __device__ __forceinline__ void operator()(const f32x4 (&acc)[2][2][4][2], const Unit& u, int wr, int wc, int fr, int fq, PG8_LAS unsigned char* lds) const {
        int lane = fr + 16 * fq, w = wr * 4 + wc; asm volatile("" : "+v"(lane));
        PG8_LAS unsigned char* const stg = lds + EPI_STG_OFF;
        const int rw = 16 * wr + fr, cw = 4 * wc + fq, woff = rw * 256 + ((cw ^ (rw & 7)) << 4);
        const int rr = 4 * w + (lane >> 4), cr = lane & 15, roff = rr * 256 + ((cr ^ (rr & 7)) << 4);
        const int grow = u.pm * BM + 64 * (rr >> 4) + (rr & 15), gcol = u.pn * BM + 8 * cr;
        const float ps = f.prescale(u);
        float rsv[2][4] = {{ps, ps, ps, ps}, {ps, ps, ps, ps}};
        if constexpr (F::ROWSCALE) { const PG8_LAS float* const rl = (const PG8_LAS float*)(lds + EPI_RS_OFF) + 64 * wr + fr;
#pragma unroll
            for (int ai = 0; ai < 2; ++ai)
#pragma unroll
                for (int m = 0; m < 4; ++m) rsv[ai][m] = rl[ai * HALF + 16 * m] * ps; }
        float mx[2] = {0.f, 0.f}, s0 = 0.f;
        constexpr int PFD = 4;
        typename F::Pre pring[PFD];
        const typename F::UPre ub0 = f.uload(gcol), ub1 = f.uload(gcol + HALF);
#pragma unroll
        for (int s = 0; s < PFD; ++s) pring[s] = f.load(grow + (s >> 3) * HALF + ((s >> 1) & 3) * 16, gcol + (s & 1) * HALF);
        auto stage = [&](int s) { const int ai = s >> 3, m = (s >> 1) & 3, bj = s & 1;
            const float sc = F::ROWSCALE ? rsv[ai][m] : ps; const f32x4 a0 = acc[ai][bj][m][0] * sc, a1 = acc[ai][bj][m][1] * sc; u32x4 pkd; pkd.x = cvt_pk_bf16(a0[0], a0[1]); pkd.y = cvt_pk_bf16(a0[2], a0[3]); pkd.z = cvt_pk_bf16(a1[0], a1[1]); pkd.w = cvt_pk_bf16(a1[2], a1[3]);
            *(PG8_LAS u32x4*)(stg + (s & 1) * 8192 + woff) = pkd; };
        stage(0);
        asm volatile("s_waitcnt lgkmcnt(0)\n\ts_barrier" ::: "memory");
        u32x4 wprev = {0u, 0u, 0u, 0u};
#pragma unroll
        for (int s = 0; s <= 16; ++s) {
            u32x4 wcur = {0u, 0u, 0u, 0u};
            if (s < 16) { wcur = *(const PG8_LAS u32x4*)(stg + (s & 1) * 8192 + roff); if (s + 1 < 16) stage(s + 1); }
            __builtin_amdgcn_sched_barrier(0);
            if (s > 0) { const int t_ = s - 1, bj = t_ & 1, row = grow + (t_ >> 3) * HALF + ((t_ >> 1) & 3) * 16, col = gcol + bj * HALF; const u32x4 wv = wprev; float v[8];
                const typename F::Pre pc = pring[t_ % PFD];
                if (t_ + PFD < 16) pring[t_ % PFD] = f.load(grow + ((t_ + PFD) >> 3) * HALF + (((t_ + PFD) >> 1) & 3) * 16, gcol + ((t_ + PFD) & 1) * HALF);
                v[0] = __uint_as_float(wv.x << 16); v[1] = __uint_as_float(wv.x & 0xffff0000u); v[2] = __uint_as_float(wv.y << 16); v[3] = __uint_as_float(wv.y & 0xffff0000u);
                v[4] = __uint_as_float(wv.z << 16); v[5] = __uint_as_float(wv.z & 0xffff0000u); v[6] = __uint_as_float(wv.w << 16); v[7] = __uint_as_float(wv.w & 0xffff0000u);
                const float sr = f.apply(row, col, v, pc, bj ? ub1 : ub0);
                if constexpr (F::HAS_SSQ) { const float t = row16_sum(sr);
                    if (bj == 0) s0 = t; else if (cr < 4) ssq[(size_t)row * 16 + (u.pn & 3) * 4 + cr] = cr == 0 ? s0 + t : 0.f; }
                if constexpr (F::HAS_NORM) { const float t = quad_sum(sr); mx[bj] = fmaxf(mx[bj], t); }
            }
            if (s + 1 < 16) asm volatile("s_waitcnt lgkmcnt(0)\n\ts_barrier" ::: "memory"); else if (s < 16) asm volatile("s_waitcnt lgkmcnt(0)" ::: "memory");
            wprev = wcur;
        }
        if constexpr (F::HAS_NORM) {
#pragma unroll
            for (int bj = 0; bj < 2; ++bj) { float t = mx[bj]; t = fmaxf(t, __shfl_xor(t, 16)); t = fmaxf(t, __shfl_xor(t, 32));
                if ((lane & 0x33) == 0) f.norm_commit(u, bj, cr >> 2, t); } }
    }
};
template <class F> struct Epi4 {
    static constexpr bool PERM = false, AFTER_DRAIN = false; F f; float* ssq;
    __device__ __forceinline__ void operator()(const f32x4 (&acc)[2][2][4][2], const Unit& u, int wr, int wc, int fr, int fq) const {
        int row0 = u.pm * BM + wr * 64 + fr, col0 = u.pn * BM + wc * 32 + 4 * fq; asm volatile("" : "+v"(row0), "+v"(col0));
#pragma unroll
        for (int ai = 0; ai < 2; ++ai)
#pragma unroll
            for (int m = 0; m < 4; ++m) { const int row = row0 + ai * HALF + m * 16; float s = 0.f;
#pragma unroll
                for (int bj = 0; bj < 2; ++bj)
#pragma unroll
                    for (int n = 0; n < 2; ++n) { float v[4];
#pragma unroll
                        for (int e = 0; e < 4; ++e) v[e] = acc[ai][bj][m][n][e];
                        s += f(row, col0 + bj * HALF + n * 16, v); }
                if (F::HAS_SSQ) { s += __shfl_xor(s, 16); s += __shfl_xor(s, 32); if (fq == 0) ssq[(size_t)row * 16 + (u.pn & 3) * 4 + wc] = s; } }
    }
};

template <class Epi, class Sched, bool ALIGN_EPI = false, bool SP2 = false>
__device__ __forceinline__ void gemm_phase(PG8_LAS unsigned char* lds, const Gemm g, const Sched& S, const Epi& E) {
    int tid_ = threadIdx.x; asm volatile("" : "+v"(tid_));
    const int tid = tid_, wid = __builtin_amdgcn_readfirstlane(tid >> 6), lane = tid & 63, wr = wid >> 2, wc = wid & 3, fr = lane & 15, fq = lane >> 4;
    const int K = g.K, nt = K / BK;
    unsigned voffA[2], voffB[2];
#pragma unroll
    for (int i = 0; i < 2; ++i) { int R, C; stage_rc(tid * 16 + i * 8192, R, C); const int Rb = Epi::PERM ? ((R & ~31) + perm32(R & 31)) : R;
        voffA[i] = (unsigned)(R * (g.a_tiled ? BK : K) + C) * 2u; voffB[i] = (unsigned)(Rb * K + C) * 2u; }
    const size_t kstep = (size_t)(BK * 2);
    const size_t hstep = (size_t)HALF * K * 2;
    const size_t kstepA = g.a_tiled ? (size_t)BM * BK * 2 : kstep, hstepA = g.a_tiled ? (size_t)HALF * BK * 2 : hstep;
    const size_t tstep = 2 * hstep;
    const unsigned ldsw = (unsigned)wid * 1024u;
    const int aoff = lds_byte(wr * 64 + fr, fq * 8), boff = lds_byte(wc * 32 + fr, fq * 8);
#define PG8_SA(b, h) (((b) * 2 + (h)) * HTB)
#define PG8_SB(b, h) ((4 + (b) * 2 + (h)) * HTB)
#define PG8_STAGE(bufoff, gbase, voff) do { _Pragma("unroll") for (int _i = 0; _i < 2; ++_i) \
        __builtin_amdgcn_global_load_lds((const unsigned*)((const char*)(gbase) + (voff)[_i]), (PG8_LAS unsigned*)(lds + (bufoff) + ldsw + _i * 8192), 16, 0, 0); } while (0)
#ifndef PG8_A_AUX
#define PG8_A_AUX 0
#endif
#define PG8_STAGE_A(bufoff, gbase, voff) do { _Pragma("unroll") for (int _i = 0; _i < 2; ++_i) \
        __builtin_amdgcn_global_load_lds((const unsigned*)((const char*)(gbase) + (voff)[_i]), (PG8_LAS unsigned*)(lds + (bufoff) + ldsw + _i * 8192), 16, 0, PG8_A_AUX); } while (0)
#define PG8_LDA(dst, b, h) do { _Pragma("unroll") for (int m = 0; m < 4; ++m) _Pragma("unroll") for (int k = 0; k < 2; ++k) dst[m][k] = *(const PG8_LAS bf16x8*)(lds + PG8_SA(b, h) + aoff + m * 2048 + k * 1024); } while (0)
#define PG8_LDB(dst, b, h) do { _Pragma("unroll") for (int n = 0; n < 2; ++n) _Pragma("unroll") for (int k = 0; k < 2; ++k) dst[n][k] = *(const PG8_LAS bf16x8*)(lds + PG8_SB(b, h) + boff + n * 2048 + k * 1024); } while (0)
#define PG8_MMA(ai, bj, At, Bt) do { __builtin_amdgcn_s_setprio(1); _Pragma("unroll") for (int m = 0; m < 4; ++m) _Pragma("unroll") for (int n = 0; n < 2; ++n) _Pragma("unroll") for (int k = 0; k < 2; ++k) \
        acc[ai][bj][m][n] = __builtin_amdgcn_mfma_f32_16x16x32_bf16(Bt[n][k], At[m][k], acc[ai][bj][m][n], 0, 0, 0); __builtin_amdgcn_s_setprio(0); } while (0)
#define PG8_WAIT_V(n) asm volatile("s_waitcnt vmcnt(" #n ")" ::: "memory")
#define PG8_WAIT_L(n) asm volatile("s_waitcnt lgkmcnt(" #n ")" ::: "memory")
#define PG8_BAR __builtin_amdgcn_s_barrier()
#define PG8_SCHED __builtin_amdgcn_sched_barrier(0)
    Unit cur, nxt; int ui = 0;
#ifdef PROBE_EPI
    unsigned pe_acc_ = 0;
#endif
    if (!S.next(0, cur)) return;
    f32x4 acc[2][2][4][2];
#pragma unroll
    for (int a = 0; a < 2; ++a)
#pragma unroll
        for (int b = 0; b < 2; ++b)
#pragma unroll
            for (int m = 0; m < 4; ++m)
#pragma unroll
                for (int n = 0; n < 2; ++n) acc[a][b][m][n] = (f32x4){0.f, 0.f, 0.f, 0.f};
    bf16x8 At[4][2], B0[2][2], B1[2][2];
    const char* cA = (const char*)g.A + (size_t)cur.pm * tstep; const char* cB = (const char*)g.Bt + (size_t)cur.pn * tstep;
    S.a_ready(cur);
    if constexpr (SP2) {
        PG8_STAGE(PG8_SB(0, 0), cB, voffB); PG8_STAGE(PG8_SB(0, 1), cB + hstep, voffB); PG8_STAGE_A(PG8_SA(0, 0), cA, voffA); PG8_STAGE_A(PG8_SA(0, 1), cA + hstepA, voffA);
        if (wr == 1) PG8_BAR;
        PG8_WAIT_V(2); PG8_BAR;
        PG8_STAGE(PG8_SB(1, 0), cB + kstep, voffB); PG8_STAGE_A(PG8_SA(1, 0), cA + kstepA, voffA); PG8_STAGE(PG8_SB(1, 1), cB + hstep + kstep, voffB);
        PG8_WAIT_V(6); PG8_BAR;
    } else {
        PG8_STAGE(PG8_SB(0, 0), cB, voffB); PG8_STAGE_A(PG8_SA(0, 0), cA, voffA); PG8_STAGE(PG8_SB(0, 1), cB + hstep, voffB); PG8_STAGE_A(PG8_SA(0, 1), cA + hstepA, voffA);
        if (wr == 1) PG8_BAR;
        PG8_WAIT_V(4); PG8_BAR;
        PG8_STAGE(PG8_SB(1, 0), cB + kstep, voffB); PG8_STAGE_A(PG8_SA(1, 0), cA + kstepA, voffA); PG8_STAGE(PG8_SB(1, 1), cB + hstep + kstep, voffB);
        PG8_WAIT_V(6); PG8_BAR;
    }
    for (;;) {
        const bool has_next = S.next(ui + 1, nxt);
        const char* nA = has_next ? (const char*)g.A + (size_t)nxt.pm * tstep : cA; const char* nB = has_next ? (const char*)g.Bt + (size_t)nxt.pn * tstep : cB;
        for (int t = 0; t < nt; t += 2) {
            const bool last = (t == nt - 2);
            const char* a1 = cA + (size_t)(t + 1) * kstepA;
            const char* a2 = last ? nA : cA + (size_t)(t + 2) * kstepA; const char* b2 = last ? nB : cB + (size_t)(t + 2) * kstep;
            const char* a3 = a2 + kstepA; const char* b3 = b2 + kstep;
            if (last && has_next) S.a_ready(nxt);
            if constexpr (SP2) {
            PG8_LDB(B0, 0, 0); PG8_LDB(B1, 0, 1); PG8_SCHED; PG8_LDA(At, 0, 0); PG8_STAGE_A(PG8_SA(1, 1), a1 + hstepA, voffA);
            PG8_WAIT_V(8); PG8_WAIT_L(0); PG8_BAR; PG8_MMA(0, 0, At, B0); PG8_MMA(0, 1, At, B1); PG8_BAR; PG8_SCHED;
            PG8_LDA(At, 0, 1); PG8_STAGE(PG8_SB(0, 0), b2, voffB); PG8_STAGE(PG8_SB(0, 1), b2 + hstep, voffB); PG8_STAGE_A(PG8_SA(0, 0), a2, voffA);
            PG8_WAIT_V(8); PG8_WAIT_L(0); PG8_BAR; PG8_MMA(1, 0, At, B0); PG8_MMA(1, 1, At, B1); PG8_BAR; PG8_SCHED;
            PG8_LDB(B0, 1, 0); PG8_LDB(B1, 1, 1); PG8_SCHED; PG8_LDA(At, 1, 0); PG8_STAGE_A(PG8_SA(0, 1), a2 + hstepA, voffA);
            PG8_WAIT_V(8); PG8_WAIT_L(0); PG8_BAR; PG8_MMA(0, 0, At, B0); PG8_MMA(0, 1, At, B1); PG8_BAR; PG8_SCHED;
            PG8_LDA(At, 1, 1); PG8_STAGE(PG8_SB(1, 0), b3, voffB); PG8_STAGE(PG8_SB(1, 1), b3 + hstep, voffB); PG8_STAGE_A(PG8_SA(1, 0), a3, voffA);
            PG8_WAIT_V(8); PG8_WAIT_L(0); PG8_BAR; PG8_MMA(1, 0, At, B0); PG8_MMA(1, 1, At, B1); PG8_BAR; PG8_SCHED;
            } else {
            PG8_LDB(B0, 0, 0); PG8_SCHED; PG8_LDA(At, 0, 0); PG8_STAGE_A(PG8_SA(1, 1), a1 + hstepA, voffA);
            PG8_WAIT_L(8); PG8_BAR; PG8_WAIT_L(0); PG8_MMA(0, 0, At, B0); PG8_BAR; PG8_SCHED;
            PG8_LDB(B1, 0, 1); PG8_STAGE(PG8_SB(0, 0), b2, voffB);
            PG8_BAR; PG8_WAIT_L(0); PG8_MMA(0, 1, At, B1); PG8_BAR;
            PG8_LDA(At, 0, 1); PG8_STAGE_A(PG8_SA(0, 0), a2, voffA);
            PG8_BAR; PG8_WAIT_L(0); PG8_MMA(1, 0, At, B0); PG8_BAR; PG8_SCHED;
            PG8_STAGE(PG8_SB(0, 1), b2 + hstep, voffB);
            PG8_WAIT_V(6); PG8_BAR; PG8_MMA(1, 1, At, B1); PG8_BAR;
            PG8_LDB(B0, 1, 0); PG8_SCHED; PG8_LDA(At, 1, 0); PG8_STAGE_A(PG8_SA(0, 1), a2 + hstepA, voffA);
            PG8_WAIT_L(8); PG8_BAR; PG8_WAIT_L(0); PG8_MMA(0, 0, At, B0); PG8_BAR; PG8_SCHED;
            PG8_LDB(B1, 1, 1); PG8_STAGE(PG8_SB(1, 0), b3, voffB);
            PG8_BAR; PG8_WAIT_L(0); PG8_MMA(0, 1, At, B1); PG8_BAR;
            PG8_LDA(At, 1, 1); PG8_STAGE_A(PG8_SA(1, 0), a3, voffA);
            PG8_BAR; PG8_WAIT_L(0); PG8_MMA(1, 0, At, B0); PG8_BAR; PG8_SCHED;
            PG8_STAGE(PG8_SB(1, 1), b3 + hstep, voffB);
            PG8_WAIT_V(6); PG8_BAR; PG8_MMA(1, 1, At, B1); PG8_BAR;
            }
        }
        if constexpr (ALIGN_EPI) { if (wr == 0) PG8_BAR; }
#ifdef PROBE_EPI
        unsigned long long pe0_ = 0; if (PROBE_EPI_COND) pe0_ = __builtin_amdgcn_s_memrealtime();
#endif
        if constexpr (!Epi::AFTER_DRAIN) { E(acc, cur, wr, wc, fr, fq, lds); S.done(cur); }
#ifdef PROBE_EPI
        if (PROBE_EPI_COND) { asm volatile("s_waitcnt vmcnt(0) lgkmcnt(0)" ::: "memory"); pe_acc_ += (unsigned)(__builtin_amdgcn_s_memrealtime() - pe0_); }
#endif
        if (!has_next) break;
#pragma unroll
        for (int a = 0; a < 2; ++a)
#pragma unroll
            for (int b = 0; b < 2; ++b)
#pragma unroll
                for (int m = 0; m < 4; ++m)
#pragma unroll
                    for (int n = 0; n < 2; ++n) acc[a][b][m][n] = (f32x4){0.f, 0.f, 0.f, 0.f};
        cur = nxt; cA = nA; cB = nB; ++ui;
        if constexpr (ALIGN_EPI) { if (wr == 1) PG8_BAR; }
    }
#ifdef PROBE_EPI
    if (PROBE_EPI_COND) { const unsigned long long t1_ = __builtin_amdgcn_s_memrealtime(); while (__builtin_amdgcn_s_memrealtime() - t1_ < (unsigned long long)pe_acc_) __builtin_amdgcn_s_sleep(10); }
#endif
    PG8_WAIT_V(0);
    if constexpr (!ALIGN_EPI) { if (wr == 0) PG8_BAR; }
    PG8_BAR;
    if constexpr (Epi::AFTER_DRAIN) { E.fused(acc, cur, wr, wc, fr, fq, lds, wid, lane); S.done(cur); }
#undef PG8_SA
#undef PG8_SB
#undef PG8_STAGE
#undef PG8_STAGE_A
#undef PG8_LDA
#undef PG8_LDB
#undef PG8_MMA
#undef PG8_WAIT_V
#undef PG8_WAIT_L
#undef PG8_BAR
#undef PG8_SCHED
}
}

#include <hip/hip_bf16.h>
#include <cmath>
namespace attn_body {
using bf16=__hip_bfloat16;
using bf16x8=__attribute__((ext_vector_type(8)))short;
using s16x4=__attribute__((ext_vector_type(4)))short;
using f32x16=__attribute__((ext_vector_type(16)))float;
using u32x4=__attribute__((ext_vector_type(4)))unsigned;
constexpr int BATCH=32,NHEAD=16,SEQ=2048,D=64,DM=NHEAD*D;
constexpr int NW=8,QBLK=32,QB=QBLK*NW,KVBLK=64,NQB=SEQ/QB;
constexpr int ATTN_PITCH=DM, ATTN_UNIT_ROWS=QB;
#ifndef ATTN_O_TILED
#define ATTN_O_TILED 0
#endif
__device__ __forceinline__ int crow(int r,int hi){return (r&3)+8*(r>>2)+4*hi;}
#define SBAR() __builtin_amdgcn_sched_barrier(0)
__device__ __forceinline__ void cmask(f32x16&p0,f32x16&p1,int jb,int qrel,int hi){
  const float NEG=-INFINITY; int kb=64*jb+4*hi;
  #pragma unroll
  for(int r=0;r<16;++r){int kv=kb+(r&3)+8*(r>>2); if(kv>qrel)p0[r]=NEG; if(kv+32>qrel)p1[r]=NEG;}
}

constexpr int NSLOT=3, SLOTB=8192;
constexpr int LDS_K=0, LDS_V=NSLOT*SLOTB, LDS_WS=2*NSLOT*SLOTB, LDS_OST=LDS_WS+NW*64*4, LDS_CUM=LDS_OST+NW*4096, LDS_AB=LDS_CUM+SEQ*4, LDS_Z=LDS_AB+128, LDS_BYTES=LDS_Z+NW*4096;
constexpr float C2=0.125f*1.4426950408889634f;
__device__ __forceinline__ void glds16(const void*gsrc,unsigned lds_dst){unsigned keep;
  asm volatile("s_mov_b32 %0, m0\n\ts_mov_b32 m0, %2\n\ts_nop 0\n\tglobal_load_lds_dwordx4 %1, off\n\ts_mov_b32 m0, %0":"=&s"(keep):"v"(gsrc),"s"(lds_dst):"memory");}
__device__ __forceinline__ float max3f(float a,float b,float c){float r;asm("v_max3_f32 %0, %1, %2, %3":"=v"(r):"v"(a),"v"(b),"v"(c));return r;}
__device__ __forceinline__ float max2f(float a,float b){float r;asm("v_max_f32_e32 %0, %1, %2":"=v"(r):"v"(a),"v"(b));return r;}
__device__ __forceinline__ float fadd_s(float a,float b){float r;asm("v_add_f32_e32 %0, %1, %2":"=v"(r):"v"(a),"v"(b));return r;}
__device__ __forceinline__ float fsub_s(float a,float b){float r;asm("v_sub_f32_e32 %0, %1, %2":"=v"(r):"v"(a),"v"(b));return r;}
typedef float f32x2_t __attribute__((ext_vector_type(2))); typedef __bf16 bf16x2_t __attribute__((ext_vector_type(2)));
__device__ __forceinline__ unsigned cvtpk_s(float lo,float hi){f32x2_t v={lo,hi};bf16x2_t b=__builtin_convertvector(v,bf16x2_t);return __builtin_bit_cast(unsigned,b);}
#define WAIT_BAR(N) asm volatile("s_waitcnt vmcnt(" #N ") lgkmcnt(0)\n\ts_barrier":::"memory")

__device__ __forceinline__ void qkt(f32x16&p0,f32x16&p1,const char*Kslot,const bf16x8*qr,int r32,int hi){
  const char*kb=Kslot+hi*1024+r32*16;
  #pragma unroll
  for(int d0=0;d0<4;++d0){
    const bf16x8 b0=*reinterpret_cast<const bf16x8*>(kb+d0*2048);
    const bf16x8 b1=*reinterpret_cast<const bf16x8*>(kb+d0*2048+512);
    p0=__builtin_amdgcn_mfma_f32_32x32x16_bf16(b0,qr[d0],p0,0,0,0);p1=__builtin_amdgcn_mfma_f32_32x32x16_bf16(b1,qr[d0],p1,0,0,0);}
}
typedef __attribute__((address_space(3))) const char* lds_cptr;
typedef short v4i16_t __attribute__((ext_vector_type(4)));
__device__ __forceinline__ void kload8(bf16x8*kf,lds_cptr kp){
  kf[0]=*(const __attribute__((address_space(3))) bf16x8*)(kp);      kf[1]=*(const __attribute__((address_space(3))) bf16x8*)(kp+512);
  kf[2]=*(const __attribute__((address_space(3))) bf16x8*)(kp+2048); kf[3]=*(const __attribute__((address_space(3))) bf16x8*)(kp+2560);
  kf[4]=*(const __attribute__((address_space(3))) bf16x8*)(kp+4096); kf[5]=*(const __attribute__((address_space(3))) bf16x8*)(kp+4608);
  kf[6]=*(const __attribute__((address_space(3))) bf16x8*)(kp+6144); kf[7]=*(const __attribute__((address_space(3))) bf16x8*)(kp+6656);
}
__device__ __forceinline__ void kload2(bf16x8*kf,lds_cptr kp,int j){ kf[2*j]=*(const __attribute__((address_space(3))) bf16x8*)(kp+j*2048); kf[2*j+1]=*(const __attribute__((address_space(3))) bf16x8*)(kp+j*2048+512); }
__device__ __forceinline__ s16x4 vtr(lds_cptr p){ return __builtin_bit_cast(s16x4,__builtin_amdgcn_ds_read_tr16_b64_v4i16((__attribute__((address_space(3))) v4i16_t*)p)); }
__device__ __forceinline__ float rowmax(const f32x16&p0,const f32x16&p1){
  float a=max3f(p0[0],p0[1],p1[0]),b=max3f(p0[2],p0[3],p1[1]);a=max3f(a,p1[2],p1[3]);
  #pragma unroll
  for(int r=4;r<16;r+=4){a=max3f(a,p0[r],p0[r+1]);b=max3f(b,p0[r+2],p0[r+3]);a=max3f(a,p1[r],p1[r+1]);b=max3f(b,p1[r+2],p1[r+3]);}
  const float m=max2f(a,b);
  auto rr=__builtin_amdgcn_permlane32_swap(__float_as_uint(m),__float_as_uint(m),false,false);
  return max2f(__uint_as_float(rr[0]),__uint_as_float(rr[1]));
}
__device__ __forceinline__ void pv(f32x16*o,int vb,bf16x8 pa0,bf16x8 pa1,bf16x8 pa2,bf16x8 pa3){
  #pragma unroll
  for(int d0=0;d0<2;++d0){s16x4 lo[4],hi[4];
    #pragma unroll
    for(int ks=0;ks<4;++ks){
      asm volatile("ds_read_b64_tr_b16 %0,%1 offset:%c2":"=&v"(lo[ks]):"v"(vb),"i"(d0*4096+ks*1024):"memory");
      asm volatile("ds_read_b64_tr_b16 %0,%1 offset:%c2":"=&v"(hi[ks]):"v"(vb),"i"(d0*4096+ks*1024+512):"memory");}
    asm volatile("s_waitcnt lgkmcnt(0)":::"memory");SBAR();
    #define PK(k) (bf16x8){lo[k][0],lo[k][1],lo[k][2],lo[k][3],hi[k][0],hi[k][1],hi[k][2],hi[k][3]}
    o[d0]=__builtin_amdgcn_mfma_f32_32x32x16_bf16(pa0,PK(0),o[d0],0,0,0);
    o[d0]=__builtin_amdgcn_mfma_f32_32x32x16_bf16(pa1,PK(1),o[d0],0,0,0);
    o[d0]=__builtin_amdgcn_mfma_f32_32x32x16_bf16(pa2,PK(2),o[d0],0,0,0);
    o[d0]=__builtin_amdgcn_mfma_f32_32x32x16_bf16(pa3,PK(3),o[d0],0,0,0);
    #undef PK
  }
}

#ifndef ATTN_STORE16
#define ATTN_STORE16(p,v) (*(u32x4*)(p)=(v))
#endif
template<int THRL> __device__ __forceinline__ void attn_unit(int b,int h,int qb,const bf16*Q,const bf16*__restrict__ K,const bf16*__restrict__ V,bf16*O,const bf16*__restrict__ Zg,const float*__restrict__ cumg,const float*qng,const float*kng,bool load_cum,char*shm){
  int tid_=threadIdx.x; asm volatile("":"+v"(tid_));
  const int tid=tid_,lane=tid&63,r32=lane&31,hi=lane>>5; const int wid=__builtin_amdgcn_readfirstlane(tid>>6);
  const long rowbase=(long)b*SEQ; const int q0=qb*QB;
  const bf16*Qw=Q+(rowbase+q0+wid*QBLK)*DM+h*D;
  const bf16*Kh=K+rowbase*DM+h*D,*Vh=V+rowbase*DM+h*D;
  const unsigned lds0=(unsigned)(uintptr_t)shm;
  float*wsf=(float*)(shm+LDS_WS)+wid*64;
  typedef __attribute__((address_space(3))) float lds_f32; typedef float f32x4_t __attribute__((ext_vector_type(4)));
  typedef __attribute__((address_space(3))) f32x4_t lds_f32x4;
  lds_f32* const cumL=(lds_f32*)((__attribute__((address_space(3))) char*)shm+LDS_CUM);
  lds_f32* const abL=(lds_f32*)((__attribute__((address_space(3))) char*)shm+LDS_AB);
  if(load_cum){
    const float* lf=cumg+((long)b*SEQ+tid*4)*NHEAD+h; float c0=lf[0],c1=c0+lf[NHEAD],c2=c1+lf[2*NHEAD],c3=c2+lf[3*NHEAD]; float inc=c3;
    #pragma unroll
    for(int o_=1;o_<64;o_<<=1){ const float t_=__shfl_up(inc,o_); if(lane>=o_)inc+=t_; }
    lds_f32* const wtot=abL+8;
    if(lane==63)wtot[wid]=inc;
    float ab=-1.f;
    if(qng&&tid<8){ const int bh_=b*NHEAD+h; const float q2=qng[(bh_*2+0)*8+tid]+qng[(bh_*2+1)*8+tid], k2=kng[bh_*2+0]+kng[bh_*2+1]; ab=2.04f*sqrtf(q2*k2); }
    if(tid<8)abL[tid]=ab;
    asm volatile("s_waitcnt lgkmcnt(0)\n\ts_barrier":::"memory");
    { float base=inc-c3;
      #pragma unroll
      for(int w_=0;w_<NW;++w_) if(w_<wid) base+=wtot[w_];
      const float L2E=1.4426950408889634f; f32x4_t cv; cv[0]=(base+c0)*L2E; cv[1]=(base+c1)*L2E; cv[2]=(base+c2)*L2E; cv[3]=(base+c3)*L2E; *(lds_f32x4*)(cumL+tid*4)=cv; }
    asm volatile("s_waitcnt vmcnt(0) lgkmcnt(0)\n\ts_barrier":::"memory"); }
  int tstart=0;
  { const float ab=abL[qb];
    if(ab>=0.f){ const float A_=ab+cumL[q0]; const int nfull=(q0+QB)/KVBLK; const bool sk=(lane<nfull-4)&&(A_-cumL[(lane<32?lane:0)*KVBLK+KVBLK-1]<-150.f);
      const unsigned long long mk=__ballot(sk); tstart=__builtin_ctzll(~mk)&~1; } tstart=__builtin_amdgcn_readfirstlane(tstart); }
  lds_f32* const cumLs=cumL+tstart*KVBLK;
  const bf16*ksrc=Kh+(long)tstart*KVBLK*DM+(long)lane*DM+wid*8;
  const bf16*vsrc=Vh+(long)tstart*KVBLK*DM+(long)(16*(wid&3)+(lane>>2))*DM+(wid>>2)*32+(lane&3)*8;
  const unsigned kdst=lds0+LDS_K+wid*1024, vdst=lds0+LDS_V+wid*1024;
  #define DMA_K(t,slot) glds16(ksrc+(long)(t)*KVBLK*DM,(unsigned)__builtin_amdgcn_readfirstlane(kdst+(slot)))
  #define DMA_V(t,slot) glds16(vsrc+(long)(t)*KVBLK*DM,(unsigned)__builtin_amdgcn_readfirstlane(vdst+(slot)))
  const int vb0=(int)(lds0+LDS_V)+((lane>>4)&1)*32+(lane&3)*8+(4*hi+((lane&15)>>2))*64;
  const char*Kbase=shm+LDS_K; bf16x8 kf[8];
  const lds_cptr shm3=(lds_cptr)shm; const lds_cptr kp0=shm3+LDS_K+hi*1024+r32*16; const lds_cptr vp0=shm3+LDS_V+((lane>>4)&1)*32+(lane&3)*8+(4*hi+((lane&15)>>2))*64;
  const int NT=(q0+QB)/KVBLK-tstart;
  { const unsigned qdst=lds0+LDS_OST+wid*4096, kddst=lds0+LDS_Z+wid*4096; const bf16*qsrc=Qw+(long)(lane>>3)*DM+(lane&7)*8; const bf16*kdsrc=Kh+(long)(q0+wid*QBLK+(lane>>3))*DM+(lane&7)*8;
    #pragma unroll
    for(int i=0;i<4;++i)glds16(qsrc+(long)i*8*DM,(unsigned)__builtin_amdgcn_readfirstlane(qdst+i*1024));
    #pragma unroll
    for(int i=0;i<4;++i)glds16(kdsrc+(long)i*8*DM,(unsigned)__builtin_amdgcn_readfirstlane(kddst+i*1024)); }
  DMA_K(0,0);DMA_V(0,0);DMA_K(1,SLOTB);
  bf16x8 qr[4];
  const float cq=cumL[q0+wid*QBLK+r32];
  float mhat=0.f;
  float l_reg=0.f;f32x16 o[2];o[0]=f32x16{};o[1]=f32x16{};
  #define CINIT(P0,P1,t) do{ const float u_=cq-mhat; const lds_f32x4* cp_=(const lds_f32x4*)(cumLs+(t)*KVBLK+4*hi); \
    _Pragma("unroll") for(int g_=0;g_<4;++g_){ const f32x4_t c0_=cp_[2*g_], c1_=cp_[8+2*g_]; \
      _Pragma("unroll") for(int i_=0;i_<4;++i_){ P0[4*g_+i_]=u_-c0_[i_]; P1[4*g_+i_]=u_-c1_[i_]; } } }while(0)
  const int qrel=wid*QBLK+r32;
  #define CMASK(P0,P1,t) do{int jb_=(t)-(NT-4); if(jb_>=0)cmask(P0,P1,jb_,qrel,hi);}while(0)
  bool resc=false;
  #define START(P0,P1) do{ const float rm=rowmax(P0,P1); resc=false; \
    if(__any(rm>(float)THRL)){ const float dl=__builtin_fmaxf(rm,0.f); mhat=fadd_s(mhat,dl); \
      _Pragma("unroll") for(int r=0;r<16;++r){P0[r]=fsub_s(P0[r],dl);P1[r]=fsub_s(P1[r],dl);} } \
    _Pragma("unroll") for(int r=0;r<16;++r)P0[r]=__builtin_amdgcn_exp2f(P0[r]); }while(0)
  #define RESC() do{ if(resc){ asm volatile("s_waitcnt lgkmcnt(0)":::"memory"); \
      _Pragma("unroll") for(int d_=0;d_<2;++d_) _Pragma("unroll") for(int r=0;r<16;++r)o[d_][r]*=wsf[crow(r,hi)]; } }while(0)
  f32x16 pA0,pA1,pB0,pB1;
  int sl_prev=0,sl_cur=0,sl_next=SLOTB;
  #define ROT() do{sl_prev=sl_cur;sl_cur=sl_next;sl_next=(sl_next==(NSLOT-1)*SLOTB)?0:sl_next+SLOTB;}while(0)
  DMA_K(2,2*SLOTB);
  WAIT_BAR(3);
  { const lds_cptr qb_=shm3+LDS_OST+wid*4096+r32*128+hi*16, kb_=shm3+LDS_Z+wid*4096+r32*128+hi*16; float dsum=0.f;
    #pragma unroll
    for(int d0=0;d0<4;++d0){ qr[d0]=*(const __attribute__((address_space(3))) bf16x8*)(qb_+d0*32); const bf16x8 kk=*(const __attribute__((address_space(3))) bf16x8*)(kb_+d0*32);
      #pragma unroll
      for(int j=0;j<8;++j) dsum+=__uint_as_float(((unsigned)(unsigned short)qr[d0][j])<<16)*__uint_as_float(((unsigned)(unsigned short)kk[j])<<16); }
    auto rr=__builtin_amdgcn_permlane32_swap(__float_as_uint(dsum),__float_as_uint(dsum),false,false);
    mhat=__uint_as_float(rr[0])+__uint_as_float(rr[1]); }
  CINIT(pA0,pA1,0);qkt(pA0,pA1,Kbase,qr,r32,hi);asm volatile("s_nop 15\n\ts_nop 7":"+v"(pA0),"+v"(pA1));CMASK(pA0,pA1,0);
  START(pA0,pA1);
  _Pragma("unroll") for(int r=0;r<16;++r)pA1[r]=__builtin_amdgcn_exp2f(pA1[r]);
  WAIT_BAR(0);
  DMA_K(3,0);DMA_V(1,SLOTB);
  ROT();
  kload8(kf,kp0+sl_cur);
  WAIT_BAR(2);
  const bf16*Zw=Zg+(rowbase+q0+wid*QBLK)*DM+h*D;
  { const unsigned zdst=lds0+LDS_Z+wid*4096; const bf16*zsrc=Zw+(long)(lane>>3)*DM+(lane&7)*8;
    #pragma unroll
    for(int i=0;i<4;++i)glds16(zsrc+(long)i*8*DM,(unsigned)__builtin_amdgcn_readfirstlane(zdst+i*1024)); }
  s16x4 vlo[8],vhi[8]; u32x4 pw0,pw1,pw2,pw3;
  #define PKW(P,B) cvtpk_s(P[B],P[B+1])
  #define PAF(k) __builtin_bit_cast(bf16x8,pw##k)
  #define VFR(i) (bf16x8){vlo[i][0],vlo[i][1],vlo[i][2],vlo[i][3],vhi[i][0],vhi[i][1],vhi[i][2],vhi[i][3]}
  #define PIN(x) asm volatile("":"+v"(x))
  #define MX3(a,b,c) __builtin_fmaxf(__builtin_fmaxf((a),(b)),(c))
  #define GAPA(MF,A0,A1,A2,A3,W0,W1,PW) do{ MF; sacc+=A0; sacc+=A1; sacc+=A2; sacc+=A3; PIN(sacc); W0; W1; PIN(PW); SBAR(); }while(0)
  #define EX(v) __builtin_amdgcn_exp2f(v)
  #define GAPB(MF,X,B) do{ MF; X[B]=EX(X[B]); X[B+1]=EX(X[B+1]); X[B+2]=EX(X[B+2]); X[B+3]=EX(X[B+3]); PIN(X); SBAR(); }while(0)
  #define VRD(i) do{ vlo[i]=vtr(vp_+(((i)>>2)*4096+((i)&3)*1024)); vhi[i]=vtr(vp_+(((i)>>2)*4096+((i)&3)*1024+512)); }while(0)
  #define KRD(G,j) do{ if(G){ kload2(kf,kp0+sl_next,j); SBAR(); } }while(0)
  #define STEP(C0,C1,P0,P1,t,GK,GV,GL) do{ SBAR(); CINIT(C0,C1,t); SBAR(); \
    const lds_cptr vp_=vp0+sl_prev; \
    VRD(0); SBAR(); float sacc=(P0[0]+P0[1]); \
    GAPA(C0=__builtin_amdgcn_mfma_f32_32x32x16_bf16(kf[0],qr[0],C0,0,0,0), P0[2],P0[3],P0[4],P0[5],     pw0[0]=PKW(P0,0), pw0[1]=PKW(P0,2), pw0); \
    VRD(4); SBAR(); GAPA(C1=__builtin_amdgcn_mfma_f32_32x32x16_bf16(kf[1],qr[0],C1,0,0,0), P0[6],P0[7],P0[8],P0[9],     pw0[2]=PKW(P0,4), pw0[3]=PKW(P0,6), pw0); \
    VRD(1); SBAR(); GAPA(C0=__builtin_amdgcn_mfma_f32_32x32x16_bf16(kf[2],qr[1],C0,0,0,0),   P0[10],P0[11],P0[12],P0[13], pw1[0]=PKW(P0,8), pw1[1]=PKW(P0,10), pw1); \
    VRD(5); SBAR(); GAPA(C1=__builtin_amdgcn_mfma_f32_32x32x16_bf16(kf[3],qr[1],C1,0,0,0),   P0[14],P0[15],P1[0],P1[1],   pw1[2]=PKW(P0,12),pw1[3]=PKW(P0,14), pw1); \
    VRD(2); SBAR(); GAPA(C0=__builtin_amdgcn_mfma_f32_32x32x16_bf16(kf[4],qr[2],C0,0,0,0),   P1[2],P1[3],P1[4],P1[5],     pw2[0]=PKW(P1,0), pw2[1]=PKW(P1,2), pw2); \
    VRD(6); SBAR(); GAPA(C1=__builtin_amdgcn_mfma_f32_32x32x16_bf16(kf[5],qr[2],C1,0,0,0),   P1[6],P1[7],P1[8],P1[9],     pw2[2]=PKW(P1,4), pw2[3]=PKW(P1,6), pw2); \
    VRD(3); SBAR(); GAPA(C0=__builtin_amdgcn_mfma_f32_32x32x16_bf16(kf[6],qr[3],C0,0,0,0),   P1[10],P1[11],P1[12],P1[13], pw3[0]=PKW(P1,8), pw3[1]=PKW(P1,10), pw3); \
    VRD(7); SBAR(); GAPA(C1=__builtin_amdgcn_mfma_f32_32x32x16_bf16(kf[7],qr[3],C1,0,0,0),   P1[14],P1[15],0.f,0.f,       pw3[2]=PKW(P1,12),pw3[3]=PKW(P1,14), pw3); \
    l_reg+=sacc; \
    if(GK){DMA_K((t)+3,sl_cur);} if(GV){DMA_V((t)+1,sl_next);} \
    CMASK(C0,C1,t); \
    { float a=MX3(C0[0],C0[1],C1[0]),b=MX3(C0[2],C0[3],C1[1]); a=MX3(a,C1[2],C1[3]); \
      _Pragma("unroll") for(int r=4;r<16;r+=4){a=MX3(a,C0[r],C0[r+1]);b=MX3(b,C0[r+2],C0[r+3]);a=MX3(a,C1[r],C1[r+1]);b=MX3(b,C1[r+2],C1[r+3]);} \
      float rm=__builtin_fmaxf(a,b); { auto rr=__builtin_amdgcn_permlane32_swap(__float_as_uint(rm),__float_as_uint(rm),false,false); rm=__builtin_fmaxf(__uint_as_float(rr[0]),__uint_as_float(rr[1])); } \
      resc=false; \
      if(__builtin_expect(__any(rm>(float)THRL),0)){ const float dl=__builtin_fmaxf(rm,0.f); mhat+=dl; \
        _Pragma("unroll") for(int r=0;r<16;++r){C0[r]-=dl;C1[r]-=dl;} \
        const float f=__builtin_amdgcn_exp2f(-dl); l_reg*=f; if(hi==0)wsf[r32]=f; resc=true; } } \
    SBAR(); \
    GAPB(o[0]=__builtin_amdgcn_mfma_f32_32x32x16_bf16(PAF(0),VFR(0),o[0],0,0,0), C0,0); \
    GAPB(o[1]=__builtin_amdgcn_mfma_f32_32x32x16_bf16(PAF(0),VFR(4),o[1],0,0,0), C0,4); \
    KRD(GL,0); GAPB(o[0]=__builtin_amdgcn_mfma_f32_32x32x16_bf16(PAF(1),VFR(1),o[0],0,0,0), C0,8); \
    KRD(GL,1); GAPB(o[1]=__builtin_amdgcn_mfma_f32_32x32x16_bf16(PAF(1),VFR(5),o[1],0,0,0), C0,12); \
    KRD(GL,2); GAPB(o[0]=__builtin_amdgcn_mfma_f32_32x32x16_bf16(PAF(2),VFR(2),o[0],0,0,0), C1,0); \
    KRD(GL,3); GAPB(o[1]=__builtin_amdgcn_mfma_f32_32x32x16_bf16(PAF(2),VFR(6),o[1],0,0,0), C1,4); \
    GAPB(o[0]=__builtin_amdgcn_mfma_f32_32x32x16_bf16(PAF(3),VFR(3),o[0],0,0,0), C1,8); \
    GAPB(o[1]=__builtin_amdgcn_mfma_f32_32x32x16_bf16(PAF(3),VFR(7),o[1],0,0,0), C1,12); \
    }while(0)
  int t=1;
  #undef CMASK
  #define CMASK(P0,P1,t) do{}while(0)
  for(;t+5<NT;t+=2){
    STEP(pB0,pB1,pA0,pA1,t,true,true,true);     WAIT_BAR(2); RESC(); ROT();
    STEP(pA0,pA1,pB0,pB1,t+1,true,true,true);   WAIT_BAR(2); RESC(); ROT();
  }
  #undef CMASK
  #define CMASK(P0,P1,t) do{int jb_=(t)-(NT-4); if(jb_>=0)cmask(P0,P1,jb_,qrel,hi);}while(0)
  #define ENDW(tt) do{ if((tt)+3<NT){WAIT_BAR(2);} else if((tt)+2<NT){WAIT_BAR(1);} else {WAIT_BAR(0);} }while(0)
  for(;t+1<NT;t+=2){
    STEP(pB0,pB1,pA0,pA1,t,(t+3<NT),(t+1<NT),(t+1<NT));       ENDW(t);   RESC(); ROT();
    STEP(pA0,pA1,pB0,pB1,t+1,(t+4<NT),(t+2<NT),(t+2<NT));     ENDW(t+1); RESC(); ROT();
  }
  STEP(pB0,pB1,pA0,pA1,NT-1,false,false,false); RESC();
  { float sacc=pB0[0]+pB0[1]; _Pragma("unroll") for(int r=2;r<16;++r)sacc+=pB0[r]; _Pragma("unroll") for(int r=0;r<16;++r)sacc+=pB1[r]; l_reg+=sacc;
    pw0=(u32x4){PKW(pB0,0),PKW(pB0,2),PKW(pB0,4),PKW(pB0,6)};pw1=(u32x4){PKW(pB0,8),PKW(pB0,10),PKW(pB0,12),PKW(pB0,14)};pw2=(u32x4){PKW(pB1,0),PKW(pB1,2),PKW(pB1,4),PKW(pB1,6)};pw3=(u32x4){PKW(pB1,8),PKW(pB1,10),PKW(pB1,12),PKW(pB1,14)};
    SBAR(); pv(o,vb0+sl_cur,PAF(0),PAF(1),PAF(2),PAF(3)); }
  #undef PKW
  #undef PAF
  #undef VFR
  #undef PIN
  #undef MX3
  #undef GAPA
  #undef GAPB
  #undef EX
  #undef VRD
  #undef KRD
  #undef STEP
  #undef ENDW
  {auto rr=__builtin_amdgcn_permlane32_swap(__float_as_uint(l_reg),__float_as_uint(l_reg),false,false);l_reg=__uint_as_float(rr[0])+__uint_as_float(rr[1]);}
  if(hi==0)wsf[32+r32]=l_reg;asm volatile("s_waitcnt lgkmcnt(0)":::"memory");
  float rli[16];
  #pragma unroll
  for(int r=0;r<16;++r)rli[r]=__builtin_amdgcn_rcpf(wsf[32+crow(r,hi)]);
#if ATTN_O_TILED
  bf16*Ow=O+((rowbase+q0)>>8)*(256L*DM)+(long)h*(256*D)+(long)(wid*QBLK)*D; constexpr int OPITCH=D;
#else
  bf16*Ow=O+(rowbase+q0+wid*QBLK)*DM+h*D; constexpr int OPITCH=DM;
#endif
  { bf16*stg=(bf16*)(shm+LDS_OST)+wid*2048;
    #pragma unroll
    for(int r=0;r<16;++r){const int orow=crow(r,hi);
      #pragma unroll
      for(int d0=0;d0<2;++d0)stg[orow*64+d0*32+r32]=__float2bfloat16(o[d0][r]*rli[r]);}
    asm volatile("s_waitcnt lgkmcnt(0)":::"memory");
    #pragma unroll
    for(int i=0;i<4;++i){const int row=i*8+(lane>>3),ch=lane&7; const u32x4 v=*(const u32x4*)(stg+row*64+ch*8); const u32x4 zz=*(const u32x4*)(shm+LDS_Z+wid*4096+i*1024+lane*16); u32x4 w;
      #pragma unroll
      for(int e=0;e<4;++e){ const float o0=__uint_as_float(v[e]<<16),o1=__uint_as_float(v[e]&0xffff0000u),z0=__uint_as_float(zz[e]<<16),z1=__uint_as_float(zz[e]&0xffff0000u);
        const float g0=o0*z0*__builtin_amdgcn_rcpf(1.f+__builtin_amdgcn_exp2f(-1.4426950408889634f*z0)), g1=o1*z1*__builtin_amdgcn_rcpf(1.f+__builtin_amdgcn_exp2f(-1.4426950408889634f*z1)); w[e]=cvtpk_s(g0,g1); }
      ATTN_STORE16(Ow+(long)row*OPITCH+ch*8,w);} }
  asm volatile("s_waitcnt lgkmcnt(0)\n\ts_barrier":::"memory");
  #undef DMA_K
  #undef DMA_V
  #undef CMASK
  #undef START
  #undef RESC
  #undef CINIT
  #undef ROT
}
constexpr int ATTN_LDS_BYTES=LDS_BYTES;
struct AttnTensors { const bf16* Q; const bf16* K; const bf16* V; bf16* O; const bf16* Z; const float* cum; const float* qn; const float* kn; };
struct AttnUnit { int bh; int qb; };
struct StaticOrder {
  int vcu,G; const int* perm;
  __device__ __forceinline__ StaticOrder(int grid,int block,const int*perm_):vcu((grid%8==0)?(block%8)*(grid/8)+block/8:block),G(grid),perm(perm_){}
  __device__ __forceinline__ bool next(int i,AttnUnit&u)const{
    if(G==BATCH*NHEAD/2){ if(i>=16)return false; const int b=vcu>>3,k=vcu&7; u.bh=b*NHEAD+perm[(i<8)?k:15-k]; u.qb=(NQB-1-(i&7)+k)&(NQB-1); return true; }
    const int j=vcu+(i>>3)*G; if(j>=BATCH*NHEAD)return false; u.bh=j; u.qb=NQB-1-(i&7); return true; }
  __device__ __forceinline__ void a_ready(const AttnUnit&)const{}
  __device__ __forceinline__ void done(const AttnUnit&)const{}
};
template<class Sched,int THRL=8> __device__ __forceinline__ void attn_phase(char*lds,const AttnTensors&T,const Sched&S){
  AttnUnit u;
  for(int i=0;S.next(i,u);++i){ S.a_ready(u); attn_unit<THRL>(u.bh/NHEAD,u.bh%NHEAD,u.qb,T.Q,T.K,T.V,T.O,T.Z,T.cum,T.qn,T.kn,(i&7)==0,lds); S.done(u); }
}
#undef SBAR
#undef WAIT_BAR
}

constexpr int NWAVES = 8;
constexpr int BATCH = 32, SEQ = 2048, DM = 1024, NH = 16, HD = 64, M = BATCH * SEQ, NIN0 = 4 * DM + NH, NIN0P = 4096, PLE = 256, NG = 64, NS = 64, GS = 16;
constexpr float RMS_EPS = 1e-6f, LOG2E = 1.4426950408889634f;
#ifndef PROBE_PHASE
#define PROBE_PHASE -1
#define PROBE_REPS 1
#endif
#ifndef ATT_THRL
#define ATT_THRL 8
#endif
#ifndef PH_FAST
#define PH_FAST 0xDEDA
#endif
constexpr size_t MiB = 1u << 20;
constexpr size_t WS_CTL = 0, CTL_ZERO_BYTES = 1 * MiB;
constexpr size_t WS_WIN0 = 2 * MiB, WS_WOUT0 = 11 * MiB, WS_WG0 = 13 * MiB, WS_WP0 = 15 * MiB, WS_WIN1 = 16 * MiB, WS_WGLU = 20 * MiB, WS_WOUT1 = 22 * MiB, WS_WG1 = 24 * MiB, WS_WP1 = 26 * MiB;
constexpr size_t WS_S5L = 27 * MiB, WS_S5BB = 27 * MiB + 256 * 1024, WS_S5B = 28 * MiB, WS_S5C = 28 * MiB + 256 * 1024;
constexpr size_t WS_HN = 32 * MiB, WS_Q = 160 * MiB, WS_K = 288 * MiB, WS_V = 416 * MiB, WS_Z = 544 * MiB;
constexpr size_t WS_PB = 672 * MiB;
constexpr size_t WS_LOGF = 736 * MiB, WS_SSQ = 740 * MiB, WS_X2 = 744 * MiB, WS_CUM = 1000 * MiB, WS_END = 1004 * MiB;
constexpr int CW_TMO = 0, CW_CODE = 1, CW_BAR = 4096, CW_GRP = 16384  , CW_QN = 65536, CW_KN = CW_QN + BATCH * NH * 2 * 8, CW_GB = 80000, GB_WORDS = 3584  ;
constexpr int RING_OFF = 0, RING_BYTES = 131072;
constexpr int LDSCTL_OFF = RING_BYTES, MISC_OFF = LDSCTL_OFF + 320;
constexpr int LDS_BYTES = 131072 + 1024 + 16384 + 1024;
static_assert(MISC_OFF + 128 <= LDSCTL_OFF + 1024 && pg8::EPI_STG_OFF == LDSCTL_OFF + 1024 && pg8::EPI_RS_OFF + 1024 <= LDS_BYTES, "LDS map");
#define GAS __attribute__((address_space(1)))
#define LAS __attribute__((address_space(3)))
typedef unsigned short bf16;
typedef unsigned v4u __attribute__((ext_vector_type(4)));
typedef float f32x4 __attribute__((ext_vector_type(4)));
typedef short bf16x8 __attribute__((ext_vector_type(8)));
typedef GAS unsigned gu32;
typedef GAS unsigned long long gu64;
#define RLX_AGENT __ATOMIC_RELAXED, __HIP_MEMORY_SCOPE_AGENT
#define LDS_WAIT() asm volatile("s_waitcnt lgkmcnt(0)" ::: "memory")
#define VM_WAIT() asm volatile("s_waitcnt vmcnt(0)" ::: "memory")
__device__ __forceinline__ unsigned long long rt() { return __builtin_amdgcn_s_memrealtime(); }
__device__ __forceinline__ unsigned f2bf(float f) { unsigned u = __builtin_bit_cast(unsigned, f); return (u + 0x7fffu + ((u >> 16) & 1u)) >> 16; }
typedef __bf16 bf16x2_t __attribute__((ext_vector_type(2)));
typedef float f32x2_t __attribute__((ext_vector_type(2)));
__device__ __forceinline__ unsigned pk2(float lo, float hi) { const f32x2_t v = {lo, hi}; return __builtin_bit_cast(unsigned, __builtin_convertvector(v, bf16x2_t)); }

#define XB_TMO      128
#define XB_XCNT(j)  (256  + 64 * (j))
#define XB_XSUB(j)  (1280 + 64 * (j))
#define XB_XGEN(j)  (2304 + 64 * (j))
#define XB_TOP      3328
#define XB_TOPGEN   3392
#define XCD_BAR_WORDS 3456
#define XB_SPIN_CAP (1u << 18)

__device__ __forceinline__ unsigned xb_ld(unsigned* p)              { return __hip_atomic_load(p, __ATOMIC_RELAXED, __HIP_MEMORY_SCOPE_AGENT); }
__device__ __forceinline__ unsigned xb_add(unsigned* p, unsigned v) { return __hip_atomic_fetch_add(p, v, __ATOMIC_RELAXED, __HIP_MEMORY_SCOPE_AGENT); }
__device__ __forceinline__ unsigned xb_xcc_id() { return (unsigned)__builtin_amdgcn_s_getreg((3 << 11) | 20) & 0xFu; }
#define XB_SPIN(cond, bar) do { unsigned _sp = 0; while (cond) { __builtin_amdgcn_s_sleep(1); \
    if ((++_sp & 255u) == 0u) { if (xb_ld(&(bar)[XB_TMO])) break; if (_sp > XB_SPIN_CAP) { atomicAdd(&(bar)[XB_TMO], 1u); break; } } } } while (0)

struct XcdBarrier {
    unsigned* bar; unsigned x;
    volatile LAS unsigned* st;
};

__device__ __forceinline__ XcdBarrier xcd_barrier_post(unsigned* bar, volatile LAS unsigned* st) {
    XcdBarrier b; b.bar = bar; b.x = xb_xcc_id(); b.st = st;
    if (threadIdx.x == 0) (void)xb_add(&bar[XB_XCNT(b.x)], 1u);
    return b;
}
__device__ __forceinline__ void xcd_barrier_complete(unsigned* bar, unsigned x, unsigned& nloc, unsigned& nx) {
    const unsigned G = gridDim.x * gridDim.y * gridDim.z;
    unsigned sum, cnt, mine, sp = 0u;
    for (;;) {
        sum = 0u; cnt = 0u; mine = 0u;
#pragma unroll
        for (unsigned j = 0; j < 16; ++j) { const unsigned c = xb_ld(&bar[XB_XCNT(j)]); sum += c; cnt += (c > 0u) ? 1u : 0u; mine = (j == x) ? c : mine; }
        if (sum == G) break;
        __builtin_amdgcn_s_sleep(1);
        if ((++sp & 255u) == 0u) { if (xb_ld(&bar[XB_TMO])) break; if (sp > XB_SPIN_CAP) { atomicAdd(&bar[XB_TMO], 1u); break; } }
    }
    nloc = mine > 0u ? mine : 1u; nx = cnt > 0u ? cnt : 1u;
}

__device__ __forceinline__ void xcd_barrier(const XcdBarrier& b) {
    asm volatile("s_waitcnt vmcnt(0)" ::: "memory");
    __syncthreads();
    if (threadIdx.x == 0) {
        unsigned* bar = b.bar;
        __builtin_amdgcn_s_waitcnt(0);
        unsigned nloc = b.st[0], nx = b.st[1];
        if (nloc == 0u) { xcd_barrier_complete(bar, b.x, nloc, nx); b.st[0] = nloc; b.st[1] = nx; }
        const unsigned old = xb_add(&bar[XB_XSUB(b.x)], 1u);
        const unsigned gen = old / nloc;
        if (old + 1u == (gen + 1u) * nloc) {
            __builtin_amdgcn_fence(__ATOMIC_RELEASE, "agent");
            asm volatile("s_waitcnt vmcnt(0)" ::: "memory");
            const unsigned og = xb_add(&bar[XB_TOP], 1u);
            const unsigned tg = og / nx;
            if (og + 1u == (tg + 1u) * nx) xb_add(&bar[XB_TOPGEN], 1u);
            else XB_SPIN(xb_ld(&bar[XB_TOPGEN]) == tg, bar);
            __builtin_amdgcn_fence(__ATOMIC_ACQUIRE, "agent");
            xb_add(&bar[XB_XGEN(b.x)], 1u);
            asm volatile("s_waitcnt vmcnt(0)" ::: "memory");
        } else {
            XB_SPIN(xb_ld(&bar[XB_XGEN(b.x)]) == gen, bar);
            __builtin_amdgcn_fence(__ATOMIC_ACQUIRE, "agent");
            asm volatile("s_waitcnt vmcnt(0)" ::: "memory");
        }
    }
    __syncthreads();
}
__device__ __forceinline__ float bf2f(unsigned short b) { return __uint_as_float((unsigned)b << 16); }
__device__ __forceinline__ float lo_f(unsigned w) { return __uint_as_float(w << 16); }
__device__ __forceinline__ float hi_f(unsigned w) { return __uint_as_float(w & 0xffff0000u); }
__device__ __forceinline__ float sigm(float v) { return __builtin_amdgcn_rcpf(1.f + __builtin_amdgcn_exp2f(-LOG2E * v)); }
__device__ __forceinline__ float gelu_tanh(float v) { return v * sigm(1.5957691216057308f * (v + 0.044715f * v * v * v)); }
__device__ __forceinline__ float logsigm(float v) { return fminf(v, 0.f) - 0.6931471805599453f * __builtin_amdgcn_logf(1.f + __builtin_amdgcn_exp2f(-LOG2E * fabsf(v))); }
__device__ __forceinline__ float wave_sum(float v) {
#pragma unroll
    for (int o = 1; o < 64; o <<= 1) v += __shfl_xor(v, o);
    return v;
}
__device__ __forceinline__ float wave_max(float v) {
#pragma unroll
    for (int o = 1; o < 64; o <<= 1) v = fmaxf(v, __shfl_xor(v, o));
    return v;
}
__device__ __forceinline__ size_t toff(int row, int col) { return (size_t)(row >> 8) * (256 * DM) + (size_t)(col >> 6) * (256 * 64) + (size_t)(row & 255) * 64 + (col & 63); }
__device__ __forceinline__ void unpack8(const v4u w, float* f) { f[0] = lo_f(w.x); f[1] = hi_f(w.x); f[2] = lo_f(w.y); f[3] = hi_f(w.y); f[4] = lo_f(w.z); f[5] = hi_f(w.z); f[6] = lo_f(w.w); f[7] = hi_f(w.w); }
__device__ __forceinline__ v4u pack8(const float* f) { v4u o; o.x = pk2(f[0], f[1]); o.y = pk2(f[2], f[3]); o.z = pk2(f[4], f[5]); o.w = pk2(f[6], f[7]); return o; }
__device__ __forceinline__ unsigned pk2_int(float lo, float hi) { return f2bf(lo) | (f2bf(hi) << 16); }
__device__ __forceinline__ v4u pack8_int(const float* f) { v4u o; o.x = pk2_int(f[0], f[1]); o.y = pk2_int(f[2], f[3]); o.z = pk2_int(f[4], f[5]); o.w = pk2_int(f[6], f[7]); return o; }

struct FInProj0 { static constexpr bool ROWSCALE = false; struct UPre {}; __device__ __forceinline__ UPre uload(int) const { return UPre{}; } static constexpr bool HAS_SSQ = false, HAS_NORM = true; bf16* base; size_t stride; const float* bfg; float* logf; unsigned* qn; unsigned* kn;
    __device__ __forceinline__ void norm_commit(const pg8::Unit& u, int bj, int wc, float v) const { if (u.pn >= 8) return; const int head = (u.pn & 3) * 4 + 2 * bj + (wc >> 1), half = wc & 1, b = u.pm >> 3, qb = u.pm & 7;
        unsigned* p = u.pn < 4 ? qn + ((size_t)((b * NH + head) * 2 + half)) * 8 + qb : kn + (size_t)((b * NH + head) * 2 + half); atomicMax(p, __float_as_uint(v)); }
    struct Pre {}; __device__ __forceinline__ Pre load(int, int) const { return Pre{}; }
    __device__ __forceinline__ float prescale(const pg8::Unit&) const { return 1.f; }
    __device__ __forceinline__ float operator()(int row, int col, const float* v) const { float w[8]; const float sc = 1.f;
#pragma unroll
        for (int e = 0; e < 8; ++e) w[e] = v[e] * sc;
        return apply(row, col, w, Pre{}, UPre{}); }
    __device__ __forceinline__ float apply(int row, int col, const float* v, const Pre&, const UPre&) const {
        const int pn_s = __builtin_amdgcn_readfirstlane(col) >> 8;
        if (pn_s < 16) { const int t = pn_s >> 2; const float sc = 1.f; float w[8];
#pragma unroll
            for (int e = 0; e < 8; ++e) w[e] = v[e] * sc;
            *(v4u*)(base + (size_t)t * stride + (size_t)row * DM + (col & (DM - 1))) = pack8_int(w);
            if (t < 2) { float s = 0.f;
#pragma unroll
                for (int e = 0; e < 8; ++e) s += w[e] * w[e];
                return s; } }
        return 0.f; }
};
template <bool SSQ, bool RS = false> struct FStore8 { static constexpr bool ROWSCALE = RS; struct UPre {};
    __device__ __forceinline__ UPre uload(int) const { return UPre{}; } static constexpr bool HAS_SSQ = SSQ, HAS_NORM = false; bf16* base; size_t stride;
    __device__ __forceinline__ float prescale(const pg8::Unit&) const { return 1.f; }
    struct Pre {}; __device__ __forceinline__ Pre load(int, int) const { return Pre{}; }
    __device__ __forceinline__ float operator()(int row, int col, const float* v) const { return apply(row, col, v, Pre{}, UPre{}); }
    __device__ __forceinline__ float apply(int row, int col, const float* v, const Pre&, const UPre&) const {
        __builtin_nontemporal_store(pack8_int(v), (v4u*)(base + (size_t)(col >> 10) * stride + (size_t)row * DM + (col & (DM - 1))));
        float s = 0.f;
        if (SSQ) {
#pragma unroll
            for (int e = 0; e < 8; ++e) s += v[e] * v[e]; }
        return s; }
};
struct FStoreRS { static constexpr bool ROWSCALE = false; struct UPre {}; __device__ __forceinline__ UPre uload(int) const { return UPre{}; } static constexpr bool HAS_SSQ = false, HAS_NORM = false; bf16* base; size_t stride; const float* rs;
    __device__ __forceinline__ float prescale(const pg8::Unit&) const { return 1.f; }
    struct Pre { float r; float pad; };
    __device__ __forceinline__ Pre load(int row, int) const { Pre p; p.r = rs[row]; p.pad = 0.f; return p; }
    __device__ __forceinline__ float operator()(int row, int col, const float* v) const { return apply(row, col, v, load(row, col), UPre{}); }
    __device__ __forceinline__ float apply(int row, int col, const float* v, const Pre& p, const UPre&) const { float w[8];
#pragma unroll
        for (int e = 0; e < 8; ++e) w[e] = v[e] * p.r;
        __builtin_nontemporal_store(pack8(w), (v4u*)(base + (size_t)(col >> 10) * stride + (size_t)row * DM + (col & (DM - 1)))); return 0.f; }
};
struct FGlu { static constexpr bool ROWSCALE = false; static constexpr bool HAS_SSQ = false, HAS_NORM = false; const bf16* g; const bf16* z; const float* bias; bf16* out; int otiled = 0, gtiled = 0;
    __device__ __forceinline__ float prescale(const pg8::Unit&) const { return 1.f; }
    struct Pre { v4u g, z; }; struct UPre { f32x4 b0, b1; };
    __device__ __forceinline__ UPre uload(int col) const { UPre q; q.b0 = *(const f32x4*)(bias + col) * -LOG2E; q.b1 = *(const f32x4*)(bias + col + 4) * -LOG2E; return q; }
    __device__ __forceinline__ Pre load(int row, int col) const { const size_t off = (size_t)row * DM + col; Pre p; p.g = __builtin_nontemporal_load((const v4u*)(g + (gtiled ? toff(row, col) : off))); p.z = __builtin_nontemporal_load((const v4u*)(z + off)); return p; }
    __device__ __forceinline__ float operator()(int row, int col, const float* v) const { return apply(row, col, v, load(row, col), uload(col)); }
    __device__ __forceinline__ float apply(int row, int col, const float* v, const Pre& p, const UPre& ub) const {
        const size_t off = (size_t)row * DM + col; float gf[8], zf[8], w[8]; unpack8(p.g, gf); unpack8(p.z, zf);
        const f32x4 b0 = ub.b0, b1 = ub.b1;
#pragma unroll
        for (int e = 0; e < 8; e += 2) {
            const f32x2_t a2 = {v[e], v[e + 1]}, bb = {e < 4 ? b0[e & 3] : b1[e & 3], e < 4 ? b0[(e & 3) + 1] : b1[(e & 3) + 1]}, g2 = {gf[e], gf[e + 1]}, z2 = {zf[e], zf[e + 1]};
            const f32x2_t ta = a2 * -LOG2E + bb, tz = z2 * -LOG2E;
            const f32x2_t ea = {__builtin_amdgcn_exp2f(ta[0]), __builtin_amdgcn_exp2f(ta[1])}, ez = {__builtin_amdgcn_exp2f(tz[0]), __builtin_amdgcn_exp2f(tz[1])};
            const f32x2_t den = (ea + 1.f) * (ez + 1.f), gz = g2 * z2;
            w[e] = gz[0] * __builtin_amdgcn_rcpf(den[0]); w[e + 1] = gz[1] * __builtin_amdgcn_rcpf(den[1]); }
        const size_t ooff = otiled ? ((size_t)(row >> 8) * 256 * DM + (size_t)(col >> 6) * (256 * 64) + (size_t)(row & 255) * 64 + (col & 63)) : off;
        __builtin_nontemporal_store(pack8(w), (v4u*)(out + ooff)); return 0.f; }
};
template <bool SSQ, bool OUT_F32> struct FGate8 { static constexpr bool ROWSCALE = false; static constexpr bool HAS_SSQ = SSQ, HAS_NORM = false; const bf16* xi; const bf16* pp; const float* bias; void* xo; int otiled = 0, xtiled = 0;
    __device__ __forceinline__ float prescale(const pg8::Unit&) const { return 1.f; }
    struct Pre { v4u x, p; }; struct UPre { f32x4 b0, b1; };
    __device__ __forceinline__ UPre uload(int col) const { UPre q; q.b0 = *(const f32x4*)(bias + col) * -LOG2E; q.b1 = *(const f32x4*)(bias + col + 4) * -LOG2E; return q; }
    __device__ __forceinline__ Pre load(int row, int col) const { const size_t off = (size_t)row * DM + col; Pre q; q.x = __builtin_nontemporal_load((const v4u*)(xi + (xtiled ? toff(row, col) : off))); q.p = __builtin_nontemporal_load((const v4u*)(pp + off)); return q; }
    __device__ __forceinline__ float operator()(int row, int col, const float* v) const { return apply(row, col, v, load(row, col), uload(col)); }
    __device__ __forceinline__ float apply(int row, int col, const float* v, const Pre& q, const UPre& ub) const {
        const size_t off = (size_t)row * DM + col; float xf[8], pf[8], o[8]; unpack8(q.x, xf); unpack8(q.p, pf);
        const f32x4 b0 = ub.b0, b1 = ub.b1;
#pragma unroll
        for (int e = 0; e < 8; e += 2) {
            const f32x2_t a2 = {v[e], v[e + 1]}, bb = {e < 4 ? b0[e & 3] : b1[e & 3], e < 4 ? b0[(e & 3) + 1] : b1[(e & 3) + 1]}, x2 = {xf[e], xf[e + 1]}, p2 = {pf[e], pf[e + 1]};
            const f32x2_t ta = a2 * -LOG2E + bb; const f32x2_t den = {1.f + __builtin_amdgcn_exp2f(ta[0]), 1.f + __builtin_amdgcn_exp2f(ta[1])};
            const f32x2_t s2 = {__builtin_amdgcn_rcpf(den[0]), __builtin_amdgcn_rcpf(den[1])}, o2 = p2 * s2 + x2; o[e] = o2[0]; o[e + 1] = o2[1]; }
        if (OUT_F32) { f32x4 o0, o1;
#pragma unroll
            for (int e = 0; e < 4; ++e) { o0[e] = o[e]; o1[e] = o[4 + e]; }
            __builtin_nontemporal_store(o0, (f32x4*)((float*)xo + off)); __builtin_nontemporal_store(o1, (f32x4*)((float*)xo + off + 4)); }
        else __builtin_nontemporal_store(pack8(o), (v4u*)((bf16*)xo + (otiled ? toff(row, col) : off)));
        float s = 0.f;
        if (SSQ) {
#pragma unroll
            for (int e = 0; e < 8; ++e) s += o[e] * o[e]; }
        return s; }
};

template <int NC, class F> __device__ __forceinline__ void naive_gemm(const bf16* A, const bf16* Bt, int Mr, int N, int K, const F& f, int gtid, int nthr) {
    const long total = (long)Mr * (N / NC);
    for (long idx = gtid; idx < total; idx += nthr) {
        const int cg = (int)(idx / Mr), r = (int)(idx % Mr);
        float acc[NC];
#pragma unroll
        for (int e = 0; e < NC; ++e) acc[e] = 0.f;
        const v4u* ap = (const v4u*)(A + (size_t)r * K);
        for (int k8 = 0; k8 < K / 8; ++k8) { float af[8]; unpack8(ap[k8], af);
#pragma unroll
            for (int e = 0; e < NC; ++e) { float bf_[8]; unpack8(*((const v4u*)(Bt + (size_t)(cg * NC + e) * K) + k8), bf_);
#pragma unroll
                for (int j = 0; j < 8; ++j) acc[e] += af[j] * bf_[j]; } }
        f(r, cg * NC, acc);
    }
}
__device__ __forceinline__ void naive_rowssq_bf16(const bf16* Y, float* ssq, int gw, int ngw, int lane) {
    for (int row = gw; row < M; row += ngw) { float f0[8], f1[8]; unpack8(((const v4u*)(Y + (size_t)row * DM))[lane], f0); unpack8(((const v4u*)(Y + (size_t)row * DM))[64 + lane], f1); float s = 0.f;
#pragma unroll
        for (int e = 0; e < 8; ++e) s += f0[e] * f0[e] + f1[e] * f1[e];
        s = wave_sum(s); if (lane < 16) ssq[(size_t)row * 16 + lane] = lane == 0 ? s : 0.f; }
}
__device__ __forceinline__ void naive_attn(const bf16* Q, const bf16* Kb, const bf16* Vb, const bf16* Z, const float* cum, bf16* O, int gw, int ngw, int lane) {
    for (int rid = gw; rid < M * NH; rid += ngw) {
        const int h = rid & 15, bt = rid >> 4, b = bt >> 11, t = bt & (SEQ - 1);
        const v4u* qp = (const v4u*)(Q + (size_t)bt * DM + h * HD); float q[64];
#pragma unroll
        for (int c = 0; c < 8; ++c) unpack8(qp[c], q + 8 * c);
        const float* cm = cum + (size_t)(b * NH + h) * SEQ; const float cq = cm[t];
        float m = -INFINITY, l = 0.f, o = 0.f;
        for (int s0 = 0; s0 <= t; s0 += 64) {
            const int s = s0 + lane; const v4u* kp = (const v4u*)(Kb + (size_t)(b * SEQ + s) * DM + h * HD); float x = 0.f;
#pragma unroll
            for (int c = 0; c < 8; ++c) { float kf[8]; unpack8(kp[c], kf);
#pragma unroll
                for (int j = 0; j < 8; ++j) x += q[8 * c + j] * kf[j]; }
            x = x + cq - cm[s]; if (s > t) x = -INFINITY;
            const float mn = fmaxf(m, wave_max(x)), alpha = __builtin_amdgcn_exp2f(m - mn), p = __builtin_amdgcn_exp2f(x - mn);
            l = l * alpha + wave_sum(p); o *= alpha;
            const bf16* vp = Vb + (size_t)(b * SEQ + s0) * DM + h * HD + lane;
#pragma unroll 8
            for (int j = 0; j < 64; ++j) o += __shfl(p, j) * bf2f(vp[(size_t)j * DM]);
            m = mn;
        }
        const float z = bf2f(Z[(size_t)bt * DM + h * HD + lane]);
        O[(size_t)bt * DM + h * HD + lane] = (bf16)f2bf(o / l * z * sigm(z));
    }
}
__device__ __forceinline__ void naive_s5(const bf16* U, const float* S5L, const float* S5BB, const float* c_re, const float* c_im, const float* dsk, bf16* G, int gw, int ngw, int lane) {
    for (int unit = gw; unit < BATCH * NG; unit += ngw) {
        const int b = unit / NG, g = unit % NG, s = lane;
        const float are = S5L[(g * NS + s) * 2], aim = S5L[(g * NS + s) * 2 + 1];
        float bre[16], bim[16], cre[16], cim[16];
#pragma unroll
        for (int j = 0; j < 16; ++j) { bre[j] = S5BB[((size_t)(g * NS + s) * 16 + j) * 2]; bim[j] = S5BB[((size_t)(g * NS + s) * 16 + j) * 2 + 1]; cre[j] = c_re[(size_t)(g * GS + j) * NS + s]; cim[j] = c_im[(size_t)(g * GS + j) * NS + s]; }
        const float dd = dsk[g * GS + (lane & 15)];
        float xr = 0.f, xi = 0.f;
        for (int t = 0; t < SEQ; ++t) {
            const bf16* up = U + (size_t)(b * SEQ + t) * DM + g * GS; float uf[16]; unpack8(((const v4u*)up)[0], uf); unpack8(((const v4u*)up)[1], uf + 8);
            float br = 0.f, bi = 0.f;
#pragma unroll
            for (int j = 0; j < 16; ++j) { br += bre[j] * uf[j]; bi += bim[j] * uf[j]; }
            const float nr = are * xr - aim * xi + br, ni = are * xi + aim * xr + bi; xr = nr; xi = ni;
            float myy = 0.f;
#pragma unroll
            for (int i = 0; i < 16; ++i) { const float v = wave_sum(cre[i] * xr - cim[i] * xi); if (lane == i) myy = v; }
            if (lane < 16) G[(size_t)(b * SEQ + t) * DM + g * GS + lane] = (bf16)f2bf(gelu_tanh(myy + dd * bf2f(up[lane])));
        }
    }
}
__device__ __forceinline__ void p0_transpose_item(const float* W, int K, int ldw, int nvalid, int nblk, bf16* WT, LAS float* scr, int item, int lane, const float* kgain = nullptr, float cscale = 1.f, int cscale_n = 0) {
    const int kb = item / nblk, nb = item % nblk, k0 = 64 * kb, n0 = 32 * nb; const int nn = n0 + (lane & 31); const bool ok = nn < nvalid;
    float wv[32];
#pragma unroll
    for (int i = 0; i < 32; ++i) { const int kk = 2 * i + (lane >> 5); wv[i] = ok ? __builtin_nontemporal_load(W + (size_t)(k0 + kk) * ldw + nn) : 0.f; }
    if (kgain) {
#pragma unroll
        for (int i = 0; i < 32; ++i) wv[i] *= kgain[k0 + 2 * i + (lane >> 5)]; }
    if (nn < cscale_n) {
#pragma unroll
        for (int i = 0; i < 32; ++i) wv[i] *= cscale; }
#pragma unroll
    for (int i = 0; i < 32; ++i) { const int kk = 2 * i + (lane >> 5); scr[kk * 33 + (lane & 31)] = wv[i]; }
    LDS_WAIT(); asm volatile("" ::: "memory");
    const int c = lane & 7;
#pragma unroll
    for (int j = 0; j < 4; ++j) { const int n = (lane >> 3) + 8 * j; const LAS float* s = scr + (8 * c) * 33 + n;
        v4u o; o.x = pk2(s[0 * 33], s[1 * 33]); o.y = pk2(s[2 * 33], s[3 * 33]); o.z = pk2(s[4 * 33], s[5 * 33]); o.w = pk2(s[6 * 33], s[7 * 33]);
        *(GAS v4u*)(WT + (size_t)(n0 + n) * K + k0 + 8 * c) = o; }
    LDS_WAIT(); asm volatile("" ::: "memory");
}
__device__ __forceinline__ void rms_row_bf16(const float* xrow, const float* gain, bf16* orow, float tot, int lane) {
    const f32x4* xr = (const f32x4*)xrow; const f32x4* gr = (const f32x4*)gain;
    f32x4 v[4] = {xr[2 * lane], xr[2 * lane + 1], xr[128 + 2 * lane], xr[128 + 2 * lane + 1]};
    if (tot < 0.f) { float s = 0.f;
#pragma unroll
        for (int j = 0; j < 4; ++j) s += (v[j][0] * v[j][0] + v[j][1] * v[j][1]) + (v[j][2] * v[j][2] + v[j][3] * v[j][3]);
        tot = wave_sum(s); }
    const float rstd = 1.0f / sqrtf(tot * (1.0f / DM) + RMS_EPS);
    const f32x4 g[4] = {gr[2 * lane], gr[2 * lane + 1], gr[128 + 2 * lane], gr[128 + 2 * lane + 1]};
    float w[16];
#pragma unroll
    for (int j = 0; j < 4; ++j)
#pragma unroll
        for (int e = 0; e < 4; ++e) w[4 * j + e] = v[j][e] * rstd * g[j][e];
    ((v4u*)orow)[lane] = pack8(w); ((v4u*)orow)[64 + lane] = pack8(w + 8);
}
template <int NR> __device__ __forceinline__ void rms_rows_nogain(const float* x0, bf16* o0, float* rms_out, size_t rstride, int lane, LAS unsigned char* img = nullptr, int pitch = 0) {
    f32x4 v[NR][4];
#pragma unroll
    for (int r = 0; r < NR; ++r) { const f32x4* xr = (const f32x4*)(x0 + r * rstride * DM); v[r][0] = __builtin_nontemporal_load(xr + 2 * lane); v[r][1] = __builtin_nontemporal_load(xr + 2 * lane + 1); v[r][2] = __builtin_nontemporal_load(xr + 128 + 2 * lane); v[r][3] = __builtin_nontemporal_load(xr + 128 + 2 * lane + 1); }
#pragma unroll
    for (int r = 0; r < NR; ++r) { float s = 0.f;
#pragma unroll
        for (int j = 0; j < 4; ++j) s += (v[r][j][0] * v[r][j][0] + v[r][j][1] * v[r][j][1]) + (v[r][j][2] * v[r][j][2] + v[r][j][3] * v[r][j][3]);
        const float rms = sqrtf(wave_sum(s) * (1.0f / DM) + RMS_EPS), rstd = 1.0f / rms;
        float w[16];
#pragma unroll
        for (int j = 0; j < 4; ++j)
#pragma unroll
            for (int e = 0; e < 4; ++e) w[4 * j + e] = v[r][j][e] * rstd;
        bf16* orow = o0 + r * rstride * DM; const v4u p0 = pack8(w), p1 = pack8(w + 8); ((v4u*)orow)[lane] = p0; ((v4u*)orow)[64 + lane] = p1;
        if (img) { ((LAS v4u*)(img + r * pitch))[lane] = p0; ((LAS v4u*)(img + r * pitch))[64 + lane] = p1; }
        if (lane == 0) rms_out[r * rstride] = rms; }
}
__device__ __forceinline__ void rms4_load(const float* x0, f32x4 (&v)[4][4], int lane) {
#pragma unroll
    for (int r = 0; r < 4; ++r) { const f32x4* xr = (const f32x4*)(x0 + (size_t)r * DM); v[r][0] = __builtin_nontemporal_load(xr + 2 * lane); v[r][1] = __builtin_nontemporal_load(xr + 2 * lane + 1); v[r][2] = __builtin_nontemporal_load(xr + 128 + 2 * lane); v[r][3] = __builtin_nontemporal_load(xr + 128 + 2 * lane + 1); }
}
__device__ __forceinline__ void rms4_finish(const f32x4 (&v)[4][4], bf16* obase, int row0, bool otiled, float* rms_out, int lane, LAS unsigned char* img, int pitch) {
#pragma unroll
    for (int r = 0; r < 4; ++r) { float s = 0.f;
#pragma unroll
        for (int j = 0; j < 4; ++j) s += (v[r][j][0] * v[r][j][0] + v[r][j][1] * v[r][j][1]) + (v[r][j][2] * v[r][j][2] + v[r][j][3] * v[r][j][3]);
        const float rms = sqrtf(wave_sum(s) * (1.0f / DM) + RMS_EPS), rstd = 1.0f / rms;
        float w[16];
#pragma unroll
        for (int j = 0; j < 4; ++j)
#pragma unroll
            for (int e = 0; e < 4; ++e) w[4 * j + e] = v[r][j][e] * rstd;
        const v4u p0 = pack8(w), p1 = pack8(w + 8);
        if (otiled) { *(v4u*)(obase + toff(row0 + r, 8 * lane)) = p0; *(v4u*)(obase + toff(row0 + r, 512 + 8 * lane)) = p1; }
        else { bf16* orow = obase + (size_t)(row0 + r) * DM; ((v4u*)orow)[lane] = p0; ((v4u*)orow)[64 + lane] = p1; }
        ((LAS v4u*)(img + r * pitch))[lane] = p0; ((LAS v4u*)(img + r * pitch))[64 + lane] = p1;
        if (lane == 0) rms_out[r] = rms; }
}
__device__ __forceinline__ void rms_row_bf16_b(const bf16* xrow, const float* gain, bf16* orow, float tot, int lane) {
    const f32x4* gr = (const f32x4*)gain; float v[16]; unpack8(((const v4u*)xrow)[lane], v); unpack8(((const v4u*)xrow)[64 + lane], v + 8);
    const float rstd = 1.0f / sqrtf(tot * (1.0f / DM) + RMS_EPS);
    const f32x4 g[4] = {gr[2 * lane], gr[2 * lane + 1], gr[128 + 2 * lane], gr[128 + 2 * lane + 1]};
    float w[16];
#pragma unroll
    for (int j = 0; j < 4; ++j)
#pragma unroll
        for (int e = 0; e < 4; ++e) w[4 * j + e] = v[4 * j + e] * rstd * g[j][e];
    ((v4u*)orow)[lane] = pack8(w); ((v4u*)orow)[64 + lane] = pack8(w + 8);
}
__device__ __forceinline__ float row_ssq_total(const float* ssq, int row, int lane) {
    float s = ssq[(size_t)row * 16 + (lane & 15)];
    s += __shfl_xor(s, 1); s += __shfl_xor(s, 2); s += __shfl_xor(s, 4); s += __shfl_xor(s, 8); return s;
}
template <bool XF32> __device__ __forceinline__ void resid_phase(const void* xi, const bf16* y, const float* ssq, const float* gain, bf16* xb, int row_lo, int row_hi, int rstep, int lane, const float* xscale = nullptr, bool xtiled = false, bool otiled = false) {
    constexpr int NR = XF32 ? 1 : 4;
    const f32x4* gr = (const f32x4*)gain; f32x4 gv[4];
#pragma unroll
    for (int j = 0; j < 4; ++j) gv[j] = gr[(j >> 1) * 128 + 2 * lane + (j & 1)];
    v4u yw[NR][2], xw[NR][2]; f32x4 xf[NR][4]; float sp[NR], xs[NR];
    auto load_group = [&](int row0) {
#pragma unroll
        for (int r = 0; r < NR; ++r) { const int row = row0 + r * rstep;
            yw[r][0] = __builtin_nontemporal_load((const v4u*)(y + (size_t)row * DM) + lane); yw[r][1] = __builtin_nontemporal_load((const v4u*)(y + (size_t)row * DM) + 64 + lane);
            if (XF32) { const f32x4* xr = (const f32x4*)((const float*)xi + (size_t)row * DM);
#pragma unroll
                for (int j = 0; j < 4; ++j) xf[r][j] = xr[(j >> 1) * 128 + 2 * lane + (j & 1)]; }
            else if (xtiled) { xw[r][0] = __builtin_nontemporal_load((const v4u*)((const bf16*)xi + toff(row, 8 * lane))); xw[r][1] = __builtin_nontemporal_load((const v4u*)((const bf16*)xi + toff(row, 512 + 8 * lane))); }
            else { xw[r][0] = __builtin_nontemporal_load((const v4u*)((const bf16*)xi + (size_t)row * DM) + lane); xw[r][1] = __builtin_nontemporal_load((const v4u*)((const bf16*)xi + (size_t)row * DM) + 64 + lane); }
            sp[r] = ssq[(size_t)row * 16 + (lane & 15)]; xs[r] = xscale ? xscale[row] : 1.f; } };
    if (row_lo < row_hi) load_group(row_lo);
    for (int row0 = row_lo; row0 < row_hi; row0 += NR * rstep) {
        v4u ow[NR][2];
#pragma unroll
        for (int r = 0; r < NR; ++r) {
            float s = sp[r]; s += __shfl_xor(s, 1); s += __shfl_xor(s, 2); s += __shfl_xor(s, 4); s += __shfl_xor(s, 8);
            const float rstd = 1.0f / sqrtf(s * (1.0f / DM) + RMS_EPS);
            float yv[16], xv[16]; unpack8(yw[r][0], yv); unpack8(yw[r][1], yv + 8);
            if (XF32) {
#pragma unroll
                for (int j = 0; j < 4; ++j)
#pragma unroll
                    for (int e = 0; e < 4; ++e) xv[4 * j + e] = xf[r][j][e]; }
            else { unpack8(xw[r][0], xv); unpack8(xw[r][1], xv + 8);
#pragma unroll
                for (int e = 0; e < 16; ++e) xv[e] *= xs[r]; }
            float w[16];
#pragma unroll
            for (int j = 0; j < 4; ++j)
#pragma unroll
                for (int e = 0; e < 4; ++e) w[4 * j + e] = xv[4 * j + e] + yv[4 * j + e] * rstd * gv[j][e];
            ow[r][0] = pack8(w); ow[r][1] = pack8(w + 8); }
        if (row0 + NR * rstep < row_hi) load_group(row0 + NR * rstep);
#pragma unroll
        for (int r = 0; r < NR; ++r) { const int row = row0 + r * rstep;
            if (otiled) { *(v4u*)(xb + toff(row, 8 * lane)) = ow[r][0]; *(v4u*)(xb + toff(row, 512 + 8 * lane)) = ow[r][1]; }
            else { ((v4u*)(xb + (size_t)row * DM))[lane] = ow[r][0]; ((v4u*)(xb + (size_t)row * DM))[64 + lane] = ow[r][1]; } }
    }
}
__device__ __forceinline__ void s5_coef(const float* lam_re, const float* lam_im, const float* log_dt, int g, int s, float& lbr, float& lbi, float& cr, float& ci) {
    const float lr = lam_re[g * NS + s], li = lam_im[g * NS + s], dt = expf(log_dt[g]);
    const float zr = lr * dt, th = li * dt, mag = expf(zr), sn = sinf(th), cs = cosf(th), sh = sinf(0.5f * th);
    lbr = mag * cs; lbi = mag * sn;
    const float nr = expm1f(zr) * cs - 2.f * sh * sh, ni = lbi, den = lr * lr + li * li;
    cr = (nr * lr + ni * li) / den; ci = (ni * lr - nr * li) / den;
}
__device__ __forceinline__ float fma_s(float a, float b, float c) { float r; asm("v_fma_f32 %0, %1, %2, %3" : "=v"(r) : "v"(a), "v"(b), "v"(c)); return r; }
__device__ __forceinline__ float mul_s(float a, float b) { float r; asm("v_mul_f32_e32 %0, %1, %2" : "=v"(r) : "v"(a), "v"(b)); return r; }
__device__ __forceinline__ float gelu_s(float v) {
    const float v2 = mul_s(v, v), w = fma_s(v2, 0.044715f * -1.5957691216057308f * LOG2E, -1.5957691216057308f * LOG2E), e = __builtin_amdgcn_exp2f(mul_s(w, v));
    return v * __builtin_amdgcn_rcpf(1.f + e); }
#ifndef S5_G_TILED
#define S5_G_TILED 0
#endif
constexpr int S5_ROWB = 272, S5_WAVE_LDS = 32 * S5_ROWB + 1024, S5_PF = 4;
static_assert(NWAVES * S5_WAVE_LDS <= RING_BYTES, "S5 LDS");
__device__ __forceinline__ void s5_phase(const bf16* __restrict__ U, const bf16* __restrict__ S5B, const bf16* __restrict__ S5C, const float* __restrict__ S5L, const float* __restrict__ dsk, bf16* __restrict__ Gout,
                                         LAS unsigned char* lds, int vcu, int G, int wave, int lane) {
    typedef float f32x16 __attribute__((ext_vector_type(16)));
    LAS unsigned char* const xs = lds + wave * S5_WAVE_LDS;
    const int n = lane & 31, h = lane >> 5, t16 = lane & 15, rq = lane >> 4;
    for (int unit = vcu; unit < BATCH * (NG / 8); unit += G) {
        const int b = unit >> 3, g = (unit & 7) * 8 + wave;
        bf16x8 bfr[4], cfr[4];
#pragma unroll
        for (int q = 0; q < 4; ++q) { bfr[q] = ((const bf16x8*)S5B)[(g * 4 + q) * 64 + lane]; cfr[q] = ((const bf16x8*)S5C)[(g * 4 + q) * 64 + lane]; }
        const int st = 2 * n + h; const float are = S5L[(g * NS + st) * 2], aim = S5L[(g * NS + st) * 2 + 1], naim = -aim;
        const f32x4 dv = *(const f32x4*)(dsk + g * GS + 4 * rq);
        float xr = 0.f, xi = 0.f;
        const bf16* ub = U + (size_t)b * SEQ * DM + g * GS; bf16* gb = Gout + (size_t)b * SEQ * DM + g * GS;
        LAS unsigned char* const us = xs + 32 * S5_ROWB;
        bf16x8 ring[S5_PF];
#pragma unroll
        for (int p = 0; p < S5_PF; ++p) ring[p] = *(const bf16x8*)(ub + (size_t)(p * 32 + n) * DM + 8 * h);
        const f32x16 Z16 = {};
        f32x16 N0 = __builtin_amdgcn_mfma_f32_32x32x16_bf16(ring[0], bfr[0], Z16, 0, 0, 0), N1 = __builtin_amdgcn_mfma_f32_32x32x16_bf16(ring[0], bfr[1], Z16, 0, 0, 0),
               N2 = __builtin_amdgcn_mfma_f32_32x32x16_bf16(ring[0], bfr[2], Z16, 0, 0, 0), N3 = __builtin_amdgcn_mfma_f32_32x32x16_bf16(ring[0], bfr[3], Z16, 0, 0, 0);
        for (int blk0 = 0; blk0 < SEQ / 32; blk0 += S5_PF) {
#pragma unroll
            for (int p = 0; p < S5_PF; ++p) {
                const int blk = blk0 + p;
                const bf16x8 acur = ring[p];
                if (blk + S5_PF < SEQ / 32) ring[p] = *(const bf16x8*)(ub + (size_t)((blk + S5_PF) * 32 + n) * DM + 8 * h);
                *(LAS bf16x8*)(us + n * 32 + 16 * h) = acur;
                f32x16 T0 = N0, T1 = N1, T2 = N2, T3 = N3;
                if (blk + 1 < SEQ / 32) { const bf16x8 an = ring[(p + 1) % S5_PF];
                    N0 = __builtin_amdgcn_mfma_f32_32x32x16_bf16(an, bfr[0], Z16, 0, 0, 0); N1 = __builtin_amdgcn_mfma_f32_32x32x16_bf16(an, bfr[1], Z16, 0, 0, 0);
                    N2 = __builtin_amdgcn_mfma_f32_32x32x16_bf16(an, bfr[2], Z16, 0, 0, 0); N3 = __builtin_amdgcn_mfma_f32_32x32x16_bf16(an, bfr[3], Z16, 0, 0, 0); }
                __builtin_amdgcn_sched_barrier(0);
#pragma unroll
                for (int r = 0; r < 16; ++r) {
                    auto a = __builtin_amdgcn_permlane32_swap(__float_as_uint(T0[r]), __float_as_uint(T2[r]), false, false); T0[r] = __uint_as_float(a[0]); T2[r] = __uint_as_float(a[1]);
                    auto c = __builtin_amdgcn_permlane32_swap(__float_as_uint(T1[r]), __float_as_uint(T3[r]), false, false); T1[r] = __uint_as_float(c[0]); T3[r] = __uint_as_float(c[1]);
                }
                LAS unsigned* const xw = (LAS unsigned*)(xs + (4 * n + 2 * h) * 2);
#pragma unroll
                for (int R = 0; R < 4; ++R) {
#pragma unroll
                    for (int i = 0; i < 4; ++i) { const int r = 4 * R + i, t = 8 * R + i; const float nr = fma_s(are, xr, fma_s(naim, xi, T0[r])), ni = fma_s(are, xi, fma_s(aim, xr, T1[r])); xr = nr; xi = ni; xw[t * (S5_ROWB / 4)] = attn_body::cvtpk_s(xr, xi); }
#pragma unroll
                    for (int i = 0; i < 4; ++i) { const int r = 4 * R + i, t = 8 * R + 4 + i; const float nr = fma_s(are, xr, fma_s(naim, xi, T2[r])), ni = fma_s(are, xi, fma_s(aim, xr, T3[r])); xr = nr; xi = ni; xw[t * (S5_ROWB / 4)] = attn_body::cvtpk_s(xr, xi); }
                }
#pragma unroll
                for (int ct = 0; ct < 2; ++ct) {
                    f32x4 y = {0.f, 0.f, 0.f, 0.f};
#pragma unroll
                    for (int ks = 0; ks < 4; ++ks) { const bf16x8 xb = *(const LAS bf16x8*)(xs + (16 * ct + t16) * S5_ROWB + 64 * ks + 16 * rq); y = __builtin_amdgcn_mfma_f32_16x16x32_bf16(cfr[ks], xb, y, 0, 0, 0); }
                    const unsigned long long uu = *(const LAS unsigned long long*)(us + (16 * ct + t16) * 32 + 8 * rq);
                    const float u0 = lo_f((unsigned)uu), u1 = hi_f((unsigned)uu), u2 = lo_f((unsigned)(uu >> 32)), u3 = hi_f((unsigned)(uu >> 32));
                    const float q0 = y[0] + dv[0] * u0, q1 = y[1] + dv[1] * u1, q2 = y[2] + dv[2] * u2, q3 = y[3] + dv[3] * u3;
                    const float g0 = gelu_s(q0), g1 = gelu_s(q1), g2 = gelu_s(q2), g3 = gelu_s(q3);
                    *(unsigned long long*)(S5_G_TILED ? Gout + toff(b * SEQ + blk * 32 + 16 * ct + t16, g * GS + 4 * rq) : gb + (size_t)(blk * 32 + 16 * ct + t16) * DM + 4 * rq) = (unsigned long long)attn_body::cvtpk_s(g0, g1) | ((unsigned long long)attn_body::cvtpk_s(g2, g3) << 32);
                }
            }
        }
    }
}
struct Args { const float* in[22]; float* out; unsigned char* ws; int ph_lo, ph_hi; };
static_assert(sizeof(Args) == 24 * 8 + 8, "Args has no padding");
constexpr int N_PHASES = 12;
__device__ __forceinline__ void grp_barrier_complete(unsigned* bar, unsigned x, unsigned total, unsigned& nloc, unsigned& nx) {
    unsigned sum, cnt, mine, sp = 0u;
    for (;;) {
        sum = 0u; cnt = 0u; mine = 0u;
#pragma unroll
        for (unsigned j = 0; j < 16; ++j) { const unsigned c = xb_ld(&bar[XB_XCNT(j)]); sum += c; cnt += (c > 0u) ? 1u : 0u; mine = (j == x) ? c : mine; }
        if (sum == total) break;
        __builtin_amdgcn_s_sleep(1);
        if ((++sp & 255u) == 0u) { if (xb_ld(&bar[XB_TMO])) break; if (sp > XB_SPIN_CAP) { atomicAdd(&bar[XB_TMO], 1u); break; } }
    }
    nloc = mine > 0u ? mine : 1u; nx = cnt > 0u ? cnt : 1u;
}
__device__ __forceinline__ void grp_barrier(const XcdBarrier& b, unsigned total) {
    asm volatile("s_waitcnt vmcnt(0)" ::: "memory");
    __syncthreads();
    if (threadIdx.x == 0) {
        unsigned* bar = b.bar;
        __builtin_amdgcn_s_waitcnt(0);
        unsigned nloc = b.st[0], nx = b.st[1];
        if (nloc == 0u) { grp_barrier_complete(bar, b.x, total, nloc, nx); b.st[0] = nloc; b.st[1] = nx; }
        const unsigned old = xb_add(&bar[XB_XSUB(b.x)], 1u);
        const unsigned gen = old / nloc;
        if (old + 1u == (gen + 1u) * nloc) {
            __builtin_amdgcn_fence(__ATOMIC_RELEASE, "agent");
            asm volatile("s_waitcnt vmcnt(0)" ::: "memory");
            const unsigned og = xb_add(&bar[XB_TOP], 1u);
            const unsigned tg = og / nx;
            if (og + 1u == (tg + 1u) * nx) xb_add(&bar[XB_TOPGEN], 1u);
            else XB_SPIN(xb_ld(&bar[XB_TOPGEN]) == tg, bar);
            __builtin_amdgcn_fence(__ATOMIC_ACQUIRE, "agent");
            xb_add(&bar[XB_XGEN(b.x)], 1u);
            asm volatile("s_waitcnt vmcnt(0)" ::: "memory");
        } else {
            XB_SPIN(xb_ld(&bar[XB_XGEN(b.x)]) == gen, bar);
            __builtin_amdgcn_fence(__ATOMIC_ACQUIRE, "agent");
            asm volatile("s_waitcnt vmcnt(0)" ::: "memory");
        }
    }
    __syncthreads();
}
__device__ __forceinline__ void batch_barrier(gu32* cnt, unsigned target, gu32* tmo) {
    asm volatile("s_waitcnt vmcnt(0)" ::: "memory"); __syncthreads();
    if (threadIdx.x == 0) {
        __builtin_amdgcn_fence(__ATOMIC_RELEASE, "agent"); asm volatile("s_waitcnt vmcnt(0)" ::: "memory");
        __hip_atomic_fetch_add(cnt, 1u, RLX_AGENT);
        unsigned sp = 0; while (__hip_atomic_load(cnt, RLX_AGENT) < target) { __builtin_amdgcn_s_sleep(1); if (++sp > (1u << 24)) { __hip_atomic_store(tmo, 1u, RLX_AGENT); break; } }
        __builtin_amdgcn_fence(__ATOMIC_ACQUIRE, "agent"); asm volatile("s_waitcnt vmcnt(0)" ::: "memory");
    }
    __syncthreads();
}
struct GroupOrder { static constexpr int IS_STATIC = 0; int p0, j, nsub;
    __device__ __forceinline__ bool next(int i, pg8::Unit& u) const { if (i >= 4 * nsub) return false; u.pm = p0 + 4 * (j >> 2) + i / nsub; u.pn = (j & 3) + 4 * (i % nsub); return true; }
    __device__ __forceinline__ void a_ready(const pg8::Unit&) const {}
    __device__ __forceinline__ void done(const pg8::Unit&) const {} };
struct PanelOrder { static constexpr int IS_STATIC = 0; int pm, nN;
    __device__ __forceinline__ bool next(int i, pg8::Unit& u) const { if (i >= nN) return false; u.pm = pm; u.pn = i; return true; }
    __device__ __forceinline__ void a_ready(const pg8::Unit&) const {}
    __device__ __forceinline__ void done(const pg8::Unit&) const {} };
__global__ void __launch_bounds__(NWAVES * 64, 2) fwd_kernel(Args args) {
    extern __shared__ __attribute__((aligned(16))) unsigned char lds[];
    LAS unsigned char* const L = (LAS unsigned char*)lds;
    volatile LAS unsigned* const MISC = (volatile LAS unsigned*)(L + MISC_OFF);
    const int tid = threadIdx.x, lane = tid & 63, wave = __builtin_amdgcn_readfirstlane(tid >> 6);
    const int G = gridDim.x, bx = blockIdx.x;
    const int gw = bx * NWAVES + wave, ngw = G * NWAVES, gtid = bx * (NWAVES * 64) + tid, nthr = G * NWAVES * 64;
    unsigned char* const ws = args.ws;
    gu32* const ctl = (gu32*)(ws + WS_CTL);
    const float* const x = args.in[0]; const float* const pin = args.in[1]; const float* const ln_pre = args.in[2]; const float* const ln_post = args.in[3];
    const float* const fox_w_in = args.in[4]; const float* const fox_b_f = args.in[5]; const float* const fox_w_out = args.in[6]; const float* const s5_w_in = args.in[7];
    const float* const lam_re = args.in[8]; const float* const lam_im = args.in[9]; const float* const log_dt = args.in[10]; const float* const b_re = args.in[11]; const float* const b_im = args.in[12];
    const float* const c_re = args.in[13]; const float* const c_im = args.in[14]; const float* const s5_d = args.in[15]; const float* const w_glu = args.in[16]; const float* const b_glu = args.in[17];
    const float* const s5_w_out = args.in[18]; const float* const ple_w_proj = args.in[19]; const float* const ple_w_gate = args.in[20]; const float* const ple_b_gate = args.in[21];
    float* const out = args.out;
    bf16* const Win0 = (bf16*)(ws + WS_WIN0); bf16* const Wout0 = (bf16*)(ws + WS_WOUT0); bf16* const Wg0 = (bf16*)(ws + WS_WG0); bf16* const Wp0 = (bf16*)(ws + WS_WP0);
    bf16* const Win1 = (bf16*)(ws + WS_WIN1); bf16* const Wglu = (bf16*)(ws + WS_WGLU); bf16* const Wout1 = (bf16*)(ws + WS_WOUT1); bf16* const Wg1 = (bf16*)(ws + WS_WG1); bf16* const Wp1 = (bf16*)(ws + WS_WP1);
    float* const S5L = (float*)(ws + WS_S5L); float* const S5BB = (float*)(ws + WS_S5BB); bf16* const S5B = (bf16*)(ws + WS_S5B); bf16* const S5C = (bf16*)(ws + WS_S5C);
    bf16* const HN = (bf16*)(ws + WS_HN); bf16* const QB_ = (bf16*)(ws + WS_Q); bf16* const KB = (bf16*)(ws + WS_K); bf16* const VB = (bf16*)(ws + WS_V); bf16* const ZB = (bf16*)(ws + WS_Z);
    bf16* const XN = (bf16*)(ws + WS_X2 + 128 * MiB); float* const RMS0 = (float*)(ws + WS_CUM + MiB);
    bf16* const PB = (bf16*)(ws + WS_PB); float* const LOGF = (float*)(ws + WS_LOGF); float* const SSQ = (float*)(ws + WS_SSQ); bf16* const X2 = (bf16*)(ws + WS_X2); float* const CUM = (float*)(ws + WS_CUM);
    constexpr size_t TSTRIDE = (WS_K - WS_Q) / 2;
    for (int u = tid; u < (LDS_BYTES - LDSCTL_OFF) / 4; u += NWAVES * 64) ((LAS unsigned*)(L + LDSCTL_OFF))[u] = 0u;
    __syncthreads();
    XcdBarrier bar = xcd_barrier_post((unsigned*)(ctl + CW_BAR), MISC + 8);
    const int lo = args.ph_lo, hi = args.ph_hi;
    const int vcu_ = (G % 8 == 0) ? (bx % 8) * (G / 8) + bx / 8 : bx;
    gu32* const bcnt = ctl + CW_GRP + (vcu_ >> 3) * 64; unsigned btarget = 0u;
    const XcdBarrier gbar = xcd_barrier_post((unsigned*)(ctl + CW_GB) + (vcu_ >> 3) * GB_WORDS, MISC + 10);
    const XcdBarrier xbar8 = xcd_barrier_post((unsigned*)(ctl + CW_GB) + (32 + (bx & 7)) * GB_WORDS, MISC + 12);
#define IN(k) (lo <= (k) && (k) < hi)
#define SEAM(k) do { if (IN(k) && (k) + 1 < hi) xcd_barrier(bar); } while (0)
#define FAST(k) (((PH_FAST) >> (k)) & 1)
#define BATCH_GROUPS (FAST(3) && FAST(10) && G == 256)
#ifdef PROBE_WAIT_SEAM
#define BSEAM(k) do { if (IN(k) && (k) + 1 < hi) { unsigned long long t0_ = 0; if ((k) == PROBE_WAIT_SEAM) { t0_ = __builtin_amdgcn_s_memrealtime(); } \
    if (BATCH_GROUPS) { grp_barrier(gbar, 8u); } else xcd_barrier(bar); \
    if ((k) == PROBE_WAIT_SEAM) { if (tid == 0) { const unsigned long long t1_ = __builtin_amdgcn_s_memrealtime(), w_ = (t1_ - t0_) * PROBE_WAIT_SCALE; while (__builtin_amdgcn_s_memrealtime() - t1_ < w_) __builtin_amdgcn_s_sleep(10); } __syncthreads(); } } } while (0)
#else
#define BSEAM(k) do { if (IN(k) && (k) + 1 < hi) { if (BATCH_GROUPS) { grp_barrier(gbar, 8u); } else xcd_barrier(bar); } } while (0)
#endif
#ifdef PROBE_RGN
#define RGN_B(id) unsigned long long rg##id##_ = 0; if ((id) == PROBE_RGN) rg##id##_ = __builtin_amdgcn_s_memrealtime();
#define RGN_E(id) if ((id) == PROBE_RGN) { if (tid == 0) { const unsigned long long t1_ = __builtin_amdgcn_s_memrealtime(), w_ = t1_ - rg##id##_; while (__builtin_amdgcn_s_memrealtime() - t1_ < w_) __builtin_amdgcn_s_sleep(10); } __syncthreads(); }
#else
#define RGN_B(id)
#define RGN_E(id)
#endif
#ifndef TILED_X2
#define TILED_X2 0
#endif
#ifndef TILED_HN
#define TILED_HN 0
#endif
#ifndef TILED_XN
#define TILED_XN 0
#endif
#ifndef TILED_A1
#define TILED_A1 1
#endif
#define REPS(k) ((k) == (PROBE_PHASE) ? (PROBE_REPS) : 1)
#define PH_BEGIN(k) if (IN(k)) { for (int rep_ = 0; rep_ < REPS(k); ++rep_) { if (rep_) xcd_barrier(bar);
#define PH_END(k) } if ((k) == 1 && BATCH_GROUPS && G == 256 && NIN0P == 4096) { if (IN(k) && (k) + 1 < hi) grp_barrier(xbar8, 32u); } else SEAM(k); }
#define WG_SYNC() do { asm volatile("s_waitcnt vmcnt(0)" ::: "memory"); __syncthreads(); } while (0)
#define PANEL_GEMM(EPI, FUNC, Aop, Bop, NN, KK, SSQP) do { int kk_ = (KK); asm volatile("" : "+s"(kk_));   pg8::Gemm g_{(const pg8::bf16_t*)(Aop), (const pg8::bf16_t*)(Bop), M, (NN), kk_}; const PanelOrder S_{pm, (NN) / 256}; \
        const EPI<decltype(FUNC)> E_{(FUNC), (SSQP)}; pg8::gemm_phase<EPI<decltype(FUNC)>, PanelOrder, true, true>(L + RING_OFF, g_, S_, E_); } while (0)
#define PANEL_GEMM_T(EPI, FUNC, Aop, Bop, NN, KK, SSQP) do { int kk_ = (KK); asm volatile("" : "+s"(kk_)); pg8::Gemm g_{(const pg8::bf16_t*)(Aop), (const pg8::bf16_t*)(Bop), M, (NN), kk_, 1}; const PanelOrder S_{pm, (NN) / 256}; \
        const EPI<decltype(FUNC)> E_{(FUNC), (SSQP)}; pg8::gemm_phase<EPI<decltype(FUNC)>, PanelOrder, true, true>(L + RING_OFF, g_, S_, E_); } while (0)
#define GROUP_GEMM(EPI, FUNC, Aop, Bop, NN, KK, SSQP, TILEDA) do { int kk_ = (KK); asm volatile("" : "+s"(kk_)); pg8::Gemm g_{(const pg8::bf16_t*)(Aop), (const pg8::bf16_t*)(Bop), M, (NN), kk_, (TILEDA)}; const GroupOrder S_{(vcu_ >> 3) * 8, vcu_ & 7, (NN) / 1024}; \
        const EPI<decltype(FUNC)> E_{(FUNC), (SSQP)}; pg8::gemm_phase<EPI<decltype(FUNC)>, GroupOrder, true, true>(L + RING_OFF, g_, S_, E_); } while (0)
#define GB() grp_barrier(gbar, 8u)
#define RUN_GEMM(k, NCV, EPI, FUNC, Aop, Bop, NN, KK, SSQP) do { \
        if (FAST(k)) { pg8::Gemm g_{(const pg8::bf16_t*)(Aop), (const pg8::bf16_t*)(Bop), M, (NN), (KK), ((k) == 1 && TILED_XN) ? 1 : 0}; pg8::StaticOrder S_; S_.init(M, (NN), G, bx); \
            const EPI<decltype(FUNC)> E_{(FUNC), (SSQP)}; pg8::gemm_phase<EPI<decltype(FUNC)>, pg8::StaticOrder, true, true>(L + RING_OFF, g_, S_, E_); } \
        else naive_gemm<NCV>((Aop), (Bop), M, (NN), (KK), (FUNC), gtid, nthr); } while (0)

    RGN_B(9999)
    PH_BEGIN(0) RGN_B(0)
        LAS float* scr = (LAS float*)(L + RING_OFF + wave * 16384);
        constexpr int I_IN0 = (DM / 64) * (NIN0P / 32), I_SQ = (DM / 64) * (DM / 32), I_IN1 = (DM / 64) * (2 * DM / 32), I_P = (PLE / 64) * (DM / 32);
        constexpr int NITEMS = I_IN0 + 5 * I_SQ + I_IN1 + 2 * I_P;
        for (int it = gw; it < NITEMS; it += ngw) {
            int r = it;
            if (r < I_IN0) { p0_transpose_item(fox_w_in, DM, NIN0, NIN0, NIN0P / 32, Win0, scr, r, lane, ln_pre, attn_body::C2, DM); continue; }     r -= I_IN0;
            if (r < I_SQ) { p0_transpose_item(fox_w_out, DM, DM, DM, DM / 32, Wout0, scr, r, lane); continue; } r -= I_SQ;
            if (r < I_SQ) { p0_transpose_item(ple_w_gate, DM, DM, DM, DM / 32, Wg0, scr, r, lane); continue; } r -= I_SQ;
            if (r < I_SQ) { p0_transpose_item(ple_w_gate + (size_t)DM * DM, DM, DM, DM, DM / 32, Wg1, scr, r, lane); continue; } r -= I_SQ;
            if (r < I_SQ) { p0_transpose_item(w_glu, DM, DM, DM, DM / 32, Wglu, scr, r, lane); continue; } r -= I_SQ;
            if (r < I_SQ) { p0_transpose_item(s5_w_out, DM, DM, DM, DM / 32, Wout1, scr, r, lane); continue; } r -= I_SQ;
            if (r < I_IN1) { p0_transpose_item(s5_w_in, DM, 2 * DM, 2 * DM, 2 * DM / 32, Win1, scr, r, lane, ln_pre + DM); continue; }     r -= I_IN1;
            if (r < I_P) { p0_transpose_item(ple_w_proj, PLE, DM, DM, DM / 32, Wp0, scr, r, lane); continue; } r -= I_P;
            p0_transpose_item(ple_w_proj + (size_t)PLE * DM, PLE, DM, DM, DM / 32, Wp1, scr, r, lane);
        }
        __syncthreads();
        { LAS v4u* const WF = (LAS v4u*)(L + RING_OFF);
          for (int c = tid; c < 32 * 64; c += NWAVES * 64) { const int ks = c >> 6, ln = c & 63, head = ln & 15, kq = ln >> 4; float w[8];
#pragma unroll
              for (int jj = 0; jj < 8; ++jj) { const int k = 32 * ks + 8 * kq + jj; w[jj] = fox_w_in[(size_t)k * NIN0 + 4 * DM + head] * ln_pre[k]; }
              WF[c] = pack8(w); }
          __syncthreads();
          pg8::bf16x8 wfr[32];
#pragma unroll
          for (int ks = 0; ks < 32; ++ks) wfr[ks] = *(const LAS pg8::bf16x8*)(WF + ks * 64 + lane);
          constexpr int IMG_PITCH = 2112;
          LAS unsigned char* const img = L + RING_OFF + 32768 + wave * (4 * IMG_PITCH);
          const LAS unsigned char* const bp = img + (lane & 3) * IMG_PITCH + 16 * (lane >> 4);
          const f32x4 bf4 = *(const f32x4*)(fox_b_f + 4 * (lane >> 4));
          f32x4 xv[4][4]; if (gw < M / 4) rms4_load(x + (size_t)(4 * gw) * DM, xv, lane);
          for (int grp = gw; grp < M / 4; grp += ngw) { const int r0 = 4 * grp;
              rms4_finish(xv, XN, r0, TILED_XN != 0, RMS0 + r0, lane, img, IMG_PITCH);
              if (grp + ngw < M / 4) rms4_load(x + (size_t)(4 * (grp + ngw)) * DM, xv, lane);
              f32x4 fa0 = {0.f, 0.f, 0.f, 0.f}, fa1 = {0.f, 0.f, 0.f, 0.f};
#pragma unroll
              for (int ks = 0; ks < 32; ks += 2) { const pg8::bf16x8 x0 = *(const LAS pg8::bf16x8*)(bp + 64 * ks), x1 = *(const LAS pg8::bf16x8*)(bp + 64 * ks + 64);
                  fa0 = __builtin_amdgcn_mfma_f32_16x16x32_bf16(wfr[ks], x0, fa0, 0, 0, 0); fa1 = __builtin_amdgcn_mfma_f32_16x16x32_bf16(wfr[ks + 1], x1, fa1, 0, 0, 0); }
              if ((lane & 15) < 4) { f32x4 o;
#pragma unroll
                  for (int i = 0; i < 4; ++i) o[i] = logsigm(fa0[i] + fa1[i] + bf4[i]);
                  *(f32x4*)(LOGF + (size_t)(r0 + (lane & 15)) * NH + 4 * (lane >> 4)) = o; } } }
        for (int t = tid * G + bx; t < NG * NS + 2 * NG * 4 * 64; t += nthr) {
            if (t < NG * NS) { const int i = t; const int g = i / NS, s = i % NS; float lbr, lbi, cr, ci; s5_coef(lam_re, lam_im, log_dt, g, s, lbr, lbi, cr, ci);
                S5L[2 * i] = lbr; S5L[2 * i + 1] = lbi;
                if (!FAST(10)) for (int j = 0; j < GS; ++j) { const float br = b_re[(size_t)i * GS + j], bi = b_im[(size_t)i * GS + j]; S5BB[((size_t)i * GS + j) * 2] = cr * br - ci * bi; S5BB[((size_t)i * GS + j) * 2 + 1] = cr * bi + ci * br; } }
            else if (t < NG * NS + NG * 4 * 64) { const int i = t - NG * NS;
                const int g = i >> 8, q = (i >> 6) & 3, ln = i & 63, n = ln & 31, h = ln >> 5, s = 2 * n + (q >> 1); float lbr, lbi, cr, ci; s5_coef(lam_re, lam_im, log_dt, g, s, lbr, lbi, cr, ci); float w[8];
                _Pragma("unroll") for (int jj = 0; jj < 8; ++jj) { const int j = 8 * h + jj; const float br = b_re[(size_t)(g * NS + s) * GS + j], bi = b_im[(size_t)(g * NS + s) * GS + j]; w[jj] = (q & 1) ? (cr * bi + ci * br) : (cr * br - ci * bi); }
                ((v4u*)S5B)[i] = pack8(w); }
            else { const int i = t - NG * NS - NG * 4 * 64;
                const int g = i >> 8, ks = (i >> 6) & 3, ln = i & 63, ch = ln & 15, kq = ln >> 4; float w[8];
                _Pragma("unroll") for (int jj = 0; jj < 8; ++jj) { const int comp = 32 * ks + 8 * kq + jj, s = comp >> 1; w[jj] = (comp & 1) ? -c_im[(size_t)(g * GS + ch) * NS + s] : c_re[(size_t)(g * GS + ch) * NS + s]; }
                ((v4u*)S5C)[i] = pack8(w); } }
    RGN_E(0) PH_END(0)
#ifdef STAGGER_TICKS
    { const unsigned long long t0_ = __builtin_amdgcn_s_memrealtime(), w_ = (unsigned long long)(bx & 7) * STAGGER_TICKS; while (__builtin_amdgcn_s_memrealtime() - t0_ < w_) __builtin_amdgcn_s_sleep(4); }
#endif
    PH_BEGIN(1) RGN_B(1) FInProj0 f{QB_, TSTRIDE, fox_b_f, LOGF, (unsigned*)(ctl + CW_QN), (unsigned*)(ctl + CW_KN)}; RUN_GEMM(1, 8, pg8::Epi8, f, XN, Win0, NIN0P, DM, nullptr); RGN_E(1) PH_END(1)
#ifdef PROBE_XBAR_G
    for (int xb_ = 0; xb_ < PROBE_XBAR_G; ++xb_) xcd_barrier(bar);
#endif
    if (!FAST(3)) {
    PH_BEGIN(2)
        for (int sq = gw; sq < BATCH * NH; sq += ngw) { const int b = sq >> 4, h = sq & 15; float v[32]; float run = 0.f;
#pragma unroll
            for (int i = 0; i < 32; ++i) { run += LOGF[(size_t)(b * SEQ + lane * 32 + i) * NH + h]; v[i] = run; }
            float incl = run;
#pragma unroll
            for (int o = 1; o < 64; o <<= 1) { const float t = __shfl_up(incl, o); if (lane >= o) incl += t; }
            const float base = incl - run;
#pragma unroll
            for (int i = 0; i < 32; i += 4) { f32x4 w; w[0] = (base + v[i]) * LOG2E; w[1] = (base + v[i + 1]) * LOG2E; w[2] = (base + v[i + 2]) * LOG2E; w[3] = (base + v[i + 3]) * LOG2E; *(f32x4*)(CUM + (size_t)sq * SEQ + lane * 32 + i) = w; } }
    PH_END(2)
    }
    PH_BEGIN(3) RGN_B(3)
        if (FAST(3)) { static_assert(attn_body::ATTN_LDS_BYTES <= RING_BYTES && attn_body::ATTN_PITCH == DM, "attention body geometry vs frame");
            const attn_body::AttnTensors AT{(const attn_body::bf16*)QB_, (const attn_body::bf16*)KB, (const attn_body::bf16*)VB, (attn_body::bf16*)HN, (const attn_body::bf16*)ZB, LOGF, FAST(1) ? (const float*)(ctl + CW_QN) : nullptr, (const float*)(ctl + CW_KN)};
            LAS int* const hperm = (LAS int*)(L + RING_OFF + attn_body::LDS_AB + 64);
            if (tid < NH) { const float my = fox_b_f[tid]; int r = 0;
#pragma unroll
                for (int j = 0; j < NH; ++j) { const float o = fox_b_f[j]; r += (o < my || (o == my && j < tid)) ? 1 : 0; }
                hperm[r] = tid; }
            __syncthreads();
            const attn_body::StaticOrder S(G, bx, (const int*)hperm);
            attn_body::attn_phase<attn_body::StaticOrder, ATT_THRL>((char*)lds + RING_OFF, AT, S);
        }
        else naive_attn(QB_, KB, VB, ZB, CUM, HN, gw, ngw, lane);
        RGN_E(3)
#ifdef PROBE_SPIN3_WORD
        if (tid == 0) { const unsigned long long ticks_ = (unsigned long long)MISC[PROBE_SPIN3_WORD] * PROBE_SPIN_SCALE, t0_ = __builtin_amdgcn_s_memrealtime(); while (__builtin_amdgcn_s_memrealtime() - t0_ < ticks_) __builtin_amdgcn_s_sleep(10); }
#endif
    } BSEAM(3); }
    PH_BEGIN(4)
        if (vcu_ < M / 256) { const int pm = vcu_;
            const int r_lo = pm * 256 + wave, r_hi = pm * 256 + 256;
            RGN_B(400)
            { constexpr int NIT = 2 * 256 * PLE / 8;
              for (int i0_ = tid; i0_ < NIT; i0_ += 8 * NWAVES * 64) { f32x4 a[8], b2[8];
#pragma unroll
                  for (int q = 0; q < 8; ++q) { const int i = i0_ + q * NWAVES * 64; const size_t e = ((size_t)(i / (256 * PLE / 8)) * M + (size_t)pm * 256) * PLE + (size_t)(i % (256 * PLE / 8)) * 8;
                      a[q] = __builtin_nontemporal_load((const f32x4*)(pin + e)); b2[q] = __builtin_nontemporal_load((const f32x4*)(pin + e + 4)); }
#pragma unroll
                  for (int q = 0; q < 8; ++q) { const int i = i0_ + q * NWAVES * 64; const size_t e = ((size_t)(i / (256 * PLE / 8)) * M + (size_t)pm * 256) * PLE + (size_t)(i % (256 * PLE / 8)) * 8;
                      v4u o; o.x = pk2(a[q][0], a[q][1]); o.y = pk2(a[q][2], a[q][3]); o.z = pk2(b2[q][0], b2[q][1]); o.w = pk2(b2[q][2], b2[q][3]); *(v4u*)(PB + e) = o; } } }
#ifdef CHAIN_STAGGER
            if (vcu_ & 1) { if (tid == 0) { const unsigned long long t0_ = __builtin_amdgcn_s_memrealtime(); while (__builtin_amdgcn_s_memrealtime() - t0_ < (unsigned long long)(CHAIN_STAGGER)) __builtin_amdgcn_s_sleep(4); } __syncthreads(); }
#endif
#ifdef GROUP_FIRST
            RGN_B(40) { FStore8<true> f{VB, 0}; GROUP_GEMM(pg8::Epi8, f, HN, Wout0, DM, DM, SSQ, ATTN_O_TILED); }
            GB(); RGN_E(40)
#else
            RGN_B(40) { FStore8<true> f{VB, 0}; if (ATTN_O_TILED) PANEL_GEMM_T(pg8::Epi8, f, HN, Wout0, DM, DM, SSQ); else PANEL_GEMM(pg8::Epi8, f, HN, Wout0, DM, DM, SSQ); }
            WG_SYNC(); RGN_E(40)
#endif
            RGN_B(41)
            resid_phase<false>(XN, VB, SSQ, ln_post, HN, r_lo, r_hi, NWAVES, lane, RMS0, TILED_XN != 0, TILED_HN != 0);
#ifdef PROBE_RESID2
            for (int rep_ = 0; rep_ < PROBE_RESID2; ++rep_) { WG_SYNC(); resid_phase<true>(x, VB, SSQ, ln_post, HN, r_lo, r_hi, NWAVES, lane); }
#endif
            RGN_E(41) RGN_B(42) { FStore8<false> f{KB, 0}; PANEL_GEMM(pg8::Epi8, f, PB, Wp0, DM, PLE, nullptr); }
            WG_SYNC(); RGN_E(42) RGN_B(43)
            { FGate8<true, false> f{HN, KB, ple_b_gate, X2, TILED_X2, TILED_HN}; if (TILED_HN) PANEL_GEMM_T(pg8::Epi8, f, HN, Wg0, DM, DM, SSQ); else PANEL_GEMM(pg8::Epi8, f, HN, Wg0, DM, DM, SSQ); }
            WG_SYNC(); RGN_E(43) RGN_B(44)
            if (tid < 256) { const int m = pm * 256 + tid; float s = 0.f;
#pragma unroll
                for (int j = 0; j < 16; ++j) s += SSQ[(size_t)m * 16 + j];
                ((LAS float*)(L + pg8::EPI_RS_OFF))[tid] = 1.0f / sqrtf(s * (1.0f / DM) + RMS_EPS); }
            __syncthreads(); RGN_E(44) RGN_B(45)
#ifdef PROBE_INPROJ2
            { const int pm_real = pm; { const int pm = (PROBE_INPROJ2) < 0 ? pm_real : (PROBE_INPROJ2); FStore8<false, true> f{HN, 0}; PANEL_GEMM(pg8::Epi8, f, X2, Win1, 2 * DM, DM, nullptr); } WG_SYNC(); }
#endif
            { FStore8<false, true> f{QB_, TSTRIDE}; if (TILED_X2) PANEL_GEMM_T(pg8::Epi8, f, X2, Win1, 2 * DM, DM, nullptr); else PANEL_GEMM(pg8::Epi8, f, X2, Win1, 2 * DM, DM, nullptr); }
            WG_SYNC(); RGN_E(45)
            RGN_E(400)
        }
    } BSEAM(4); }
    PH_BEGIN(10) RGN_B(10) if (FAST(10)) { const int vcu = (G % 8 == 0) ? (bx % 8) * (G / 8) + bx / 8 : bx; s5_phase(QB_, S5B, S5C, S5L, s5_d, VB, L + RING_OFF, vcu, G, wave, lane); }
                  else naive_s5(QB_, S5L, S5BB, c_re, c_im, s5_d, VB, gw, ngw, lane);
    RGN_E(10) } BSEAM(10);
#ifdef PROBE_XBAR_B
    for (int xb_ = 0; xb_ < PROBE_XBAR_B; ++xb_) { grp_barrier(gbar, 8u); }
#endif
    }
    if (IN(11)) {
        if (vcu_ < M / 256) { const int pm = vcu_;
            const int r_lo = pm * 256 + wave, r_hi = pm * 256 + 256;
            RGN_B(1100)
#ifdef CHAIN_STAGGER
            if (vcu_ & 1) { if (tid == 0) { const unsigned long long t0_ = __builtin_amdgcn_s_memrealtime(); while (__builtin_amdgcn_s_memrealtime() - t0_ < (unsigned long long)(CHAIN_STAGGER)) __builtin_amdgcn_s_sleep(4); } __syncthreads(); }
#endif
#ifdef GROUP_FIRST
            RGN_B(50) { FGlu f{VB, KB, b_glu, ZB, TILED_A1, S5_G_TILED}; GROUP_GEMM(pg8::Epi8, f, VB, Wglu, DM, DM, nullptr, S5_G_TILED); }
            GB(); RGN_E(50) RGN_B(51)
#else
            RGN_B(50) { FGlu f{VB, KB, b_glu, ZB, TILED_A1, S5_G_TILED}; if (S5_G_TILED) PANEL_GEMM_T(pg8::Epi8, f, VB, Wglu, DM, DM, nullptr); else PANEL_GEMM(pg8::Epi8, f, VB, Wglu, DM, DM, nullptr); }
            WG_SYNC(); RGN_E(50) RGN_B(51)
#endif
            { FStore8<true> f{QB_, 0}; if (TILED_A1) PANEL_GEMM_T(pg8::Epi8, f, ZB, Wout1, DM, DM, SSQ); else PANEL_GEMM(pg8::Epi8, f, ZB, Wout1, DM, DM, SSQ); }
            WG_SYNC(); RGN_E(51) RGN_B(52)
            resid_phase<false>(X2, QB_, SSQ, ln_post + DM, HN, r_lo, r_hi, NWAVES, lane, nullptr, TILED_X2 != 0, TILED_HN != 0);
#ifdef PROBE_RESID2
            for (int rep_ = 0; rep_ < PROBE_RESID2; ++rep_) { WG_SYNC(); resid_phase<false>(X2, QB_, SSQ, ln_post + DM, HN, r_lo, r_hi, NWAVES, lane); }
#endif
            RGN_E(52) RGN_B(53) { FStore8<false> f{KB, 0}; PANEL_GEMM(pg8::Epi8, f, PB + (size_t)M * PLE, Wp1, DM, PLE, nullptr); }
            WG_SYNC(); RGN_E(53) RGN_B(54)
            { FGate8<false, true> f{HN, KB, ple_b_gate + DM, out, 0, TILED_HN}; if (TILED_HN) PANEL_GEMM_T(pg8::Epi8, f, HN, Wg1, DM, DM, nullptr); else PANEL_GEMM(pg8::Epi8, f, HN, Wg1, DM, DM, nullptr); }
            WG_SYNC(); RGN_E(54)
            RGN_E(1100)
        }
    }
    RGN_E(9999)
#ifdef PROBE_SPINEND_WORD
    if (tid == 0) { const unsigned long long ticks_ = (unsigned long long)MISC[PROBE_SPINEND_WORD], t0_ = __builtin_amdgcn_s_memrealtime(); while (__builtin_amdgcn_s_memrealtime() - t0_ < ticks_) __builtin_amdgcn_s_sleep(10); }
#endif
#undef IN
#undef SEAM
#undef BSEAM
#undef BATCH_GROUPS
#undef FAST
#undef RUN_GEMM
#undef PANEL_GEMM
#undef WG_SYNC
#undef REPS
#undef PH_BEGIN
#undef PH_END
}

extern "C" void kernel_launch(void* const* d_in, const int* in_sizes, int n_in, void* d_out, int out_size, void* d_ws, size_t ws_size, hipStream_t stream) {
    static int grid = 0;
    if (grid == 0) {
        if (n_in != 22 || in_sizes[0] != M * DM || out_size != M * DM || ws_size < WS_END) { fprintf(stderr, "kernel_launch: built for 22 inputs, x/out of %d floats, >= %zu bytes of workspace; got n_in %d, in0 %d, out %d, ws %zu; nothing launched\n", M * DM, (size_t)WS_END, n_in, n_in > 0 ? in_sizes[0] : -1, out_size, ws_size); grid = -1; return; }
        int dev = 0, cus = 0, per_cu = 0;
        if (hipGetDevice(&dev) != hipSuccess || hipDeviceGetAttribute(&cus, hipDeviceAttributeMultiprocessorCount, dev) != hipSuccess) { fprintf(stderr, "kernel_launch: hipGetDevice / hipDeviceGetAttribute failed\n"); grid = -1; return; }
        if (hipFuncSetAttribute((const void*)fwd_kernel, hipFuncAttributeMaxDynamicSharedMemorySize, LDS_BYTES) != hipSuccess) { fprintf(stderr, "kernel_launch: hipFuncSetAttribute failed\n"); grid = -1; return; }
        if (hipOccupancyMaxActiveBlocksPerMultiprocessor(&per_cu, (const void*)fwd_kernel, NWAVES * 64, LDS_BYTES) != hipSuccess || per_cu < 1) { fprintf(stderr, "kernel_launch: occupancy query reports %d workgroups per CU; nothing launched\n", per_cu); (void)hipGetLastError(); grid = -1; return; }
        if (cus < M / 256) { fprintf(stderr, "kernel_launch: this build needs >= %d CUs (one 256-row panel per workgroup in the chain phases); device has %d; nothing launched\n", M / 256, cus); grid = -1; return; }
        grid = cus;
    }
    if (grid < 0) return;
    if (hipMemsetAsync((char*)d_ws + WS_CTL, 0, CTL_ZERO_BYTES, stream) != hipSuccess) { fprintf(stderr, "kernel_launch: hipMemsetAsync failed\n"); return; }
    Args a{};
    for (int i = 0; i < 22; ++i) a.in[i] = (const float*)d_in[i];
    a.out = (float*)d_out; a.ws = (unsigned char*)d_ws; a.ph_lo = 0; a.ph_hi = N_PHASES;
    hipLaunchKernelGGL(fwd_kernel, dim3(grid), dim3(NWAVES * 64), LDS_BYTES, stream, a);
    const hipError_t le = hipPeekAtLastError();
    if (le != hipSuccess) fprintf(stderr, "kernel_launch: launch failed: %s\n", hipGetErrorName(le));
}
```
